# Optimizing an MI355X kernel written in HIP

```python
import math
import jax, jax.numpy as jnp
from jax import lax
import numpy as np

D_MODEL = 1024
BATCH = 2
SEQ = 16384
DEPTH = 4

MIX_WIDTH = D_MODEL
S5_WIDTH = D_MODEL // 4
S5_GROUP_DIM = 16
S5_GROUPS = S5_WIDTH // S5_GROUP_DIM
S5_STATE = 64
SSD_INNER = MIX_WIDTH - S5_WIDTH
SSD_HEAD_DIM = 64
SSD_HEADS = SSD_INNER // SSD_HEAD_DIM
SSD_GROUPS = 4
SSD_HPG = SSD_HEADS // SSD_GROUPS
SSD_STATE = 128
SSD_CONV = 4
SSD_CHUNK = 128
SSD_CONV_DIM = SSD_INNER + 2 * SSD_GROUPS * SSD_STATE
IN_COLS = S5_WIDTH + SSD_INNER + SSD_CONV_DIM + SSD_HEADS
MEM_LEN = 256
XA_HEADS = 4
XA_HEAD_DIM = D_MODEL // XA_HEADS
D_FF = 256 * ((8 * D_MODEL // 3 + 255) // 256)
FFN_CONV = 3
NORM_EPS = 1e-6

kernel_name = "hybrid_s5_ssd_xattn_convffn"


def rmsnorm(x, w):
    xf = x.astype(jnp.float32)
    xf = xf * lax.rsqrt(jnp.mean(xf * xf, axis=-1, keepdims=True) + NORM_EPS)
    return (xf * w.astype(jnp.float32)).astype(x.dtype)


def causal_dwconv(x, w, b):
    k = w.shape[0]
    l = x.shape[1]
    xp = jnp.pad(x, ((0, 0), (k - 1, 0), (0, 0)))
    y = xp[:, 0:l] * w[0]
    for i in range(1, k):
        y = y + xp[:, i:i + l] * w[i]
    return y + b


def s5_mixer(u, lam_re, lam_im, log_dt, b_re, b_im, c_re, c_im, d_skip, w_glu):
    bsz, l, _ = u.shape
    f32 = jnp.float32
    uf = u.reshape(bsz, l, S5_GROUPS, S5_GROUP_DIM).astype(f32)
    lr = jnp.minimum(lam_re.astype(f32), -1e-4)
    li = lam_im.astype(f32)
    dt = jnp.exp(log_dt.astype(f32))[:, None]
    mag = jnp.exp(lr * dt)
    ab_re = mag * jnp.cos(li * dt)
    ab_im = mag * jnp.sin(li * dt)
    den = lr * lr + li * li
    f_re = ((ab_re - 1.0) * lr + ab_im * li) / den
    f_im = (ab_im * lr - (ab_re - 1.0) * li) / den
    br = b_re.astype(f32)
    bi = b_im.astype(f32)
    bb_re = f_re[..., None] * br - f_im[..., None] * bi
    bb_im = f_re[..., None] * bi + f_im[..., None] * br
    bu_re = jnp.einsum('blgc,gpc->blgp', uf, bb_re)
    bu_im = jnp.einsum('blgc,gpc->blgp', uf, bb_im)
    a_re = jnp.broadcast_to(ab_re, bu_re.shape)
    a_im = jnp.broadcast_to(ab_im, bu_im.shape)

    def combine(e1, e2):
        a1r, a1i, b1r, b1i = e1
        a2r, a2i, b2r, b2i = e2
        return (a2r * a1r - a2i * a1i,
                a2r * a1i + a2i * a1r,
                a2r * b1r - a2i * b1i + b2r,
                a2r * b1i + a2i * b1r + b2i)

    _, _, h_re, h_im = lax.associative_scan(combine, (a_re, a_im, bu_re, bu_im), axis=1)
    y = (jnp.einsum('blgp,gcp->blgc', h_re, c_re.astype(f32))
         - jnp.einsum('blgp,gcp->blgc', h_im, c_im.astype(f32)))
    y = y + uf * d_skip.astype(f32).reshape(S5_GROUPS, S5_GROUP_DIM)
    y = jax.nn.gelu(y.reshape(bsz, l, S5_WIDTH))
    y = y * jax.nn.sigmoid(y @ w_glu.astype(f32))
    return y.astype(u.dtype)


def ssd_mixer(z, xbc, dt_raw, conv_w, conv_b, dt_bias, a_log, d_skip, norm_w):
    bsz, l, _ = xbc.shape
    f32 = jnp.float32
    nc = l // SSD_CHUNK
    xbc = jax.nn.silu(causal_dwconv(xbc, conv_w, conv_b))
    xs = xbc[..., :SSD_INNER]
    bmat = xbc[..., SSD_INNER:SSD_INNER + SSD_GROUPS * SSD_STATE]
    cmat = xbc[..., SSD_INNER + SSD_GROUPS * SSD_STATE:]
    x = xs.reshape(bsz, nc, SSD_CHUNK, SSD_GROUPS, SSD_HPG, SSD_HEAD_DIM)
    bm = bmat.reshape(bsz, nc, SSD_CHUNK, SSD_GROUPS, SSD_STATE)
    cm = cmat.reshape(bsz, nc, SSD_CHUNK, SSD_GROUPS, SSD_STATE)
    dt = jax.nn.softplus(dt_raw.astype(f32) + dt_bias.astype(f32))
    a = -jnp.exp(a_log.astype(f32))
    dt_c = dt.reshape(bsz, nc, SSD_CHUNK, SSD_GROUPS, SSD_HPG)
    da = jnp.moveaxis(dt_c * a.reshape(SSD_GROUPS, SSD_HPG), 2, -1)
    a_cs = jnp.cumsum(da, axis=-1)
    xdt = x.astype(f32) * dt_c[..., None]
    seg = a_cs[..., :, None] - a_cs[..., None, :]
    causal = jnp.tril(jnp.ones((SSD_CHUNK, SSD_CHUNK), dtype=bool))
    lmat = jnp.exp(jnp.where(causal, seg, -jnp.inf))
    cb = jnp.einsum('bclgn,bcsgn->bcgls', cm.astype(f32), bm.astype(f32))
    y_diag = jnp.einsum('bcgls,bcghls,bcsghp->bclghp', cb, lmat, xdt)
    decay_states = jnp.exp(a_cs[..., -1:] - a_cs)
    states = jnp.einsum('bclgn,bcghl,bclghp->bcghpn', bm.astype(f32), decay_states, xdt)
    chunk_decay = jnp.exp(a_cs[..., -1])

    def step(carry, inp):
        st, dec = inp
        return carry * dec[..., None, None] + st, carry

    init = jnp.zeros((bsz, SSD_GROUPS, SSD_HPG, SSD_HEAD_DIM, SSD_STATE), f32)
    _, prev = lax.scan(step, init, (jnp.moveaxis(states, 1, 0), jnp.moveaxis(chunk_decay, 1, 0)))
    prev = jnp.moveaxis(prev, 0, 1)
    y_off = jnp.einsum('bclgn,bcghpn,bcghl->bclghp', cm.astype(f32), prev, jnp.exp(a_cs))
    y = y_diag + y_off + x.astype(f32) * d_skip.astype(f32).reshape(SSD_GROUPS, SSD_HPG)[:, :, None]
    y = y.reshape(bsz, l, SSD_INNER).astype(z.dtype)
    return rmsnorm(y * jax.nn.silu(z), norm_w)


def cross_attention(h, mem_n, wq, wk, wv, wo):
    bsz, l, _ = h.shape
    m = mem_n.shape[1]
    q = (h @ wq).reshape(bsz, l, XA_HEADS, XA_HEAD_DIM)
    k = (mem_n @ wk).reshape(bsz, m, XA_HEADS, XA_HEAD_DIM)
    v = (mem_n @ wv).reshape(bsz, m, XA_HEADS, XA_HEAD_DIM)
    s = jnp.einsum('blhd,bmhd->bhlm', q, k).astype(jnp.float32) * (XA_HEAD_DIM ** -0.5)
    p = jax.nn.softmax(s, axis=-1).astype(v.dtype)
    o = jnp.einsum('bhlm,bmhd->blhd', p, v).reshape(bsz, l, D_MODEL)
    return o @ wo


def conv_ffn(h, w_up, conv_w, conv_b, w_down):
    gv = h @ w_up
    g = causal_dwconv(gv[..., :D_FF], conv_w, conv_b)
    v = gv[..., D_FF:]
    return (jax.nn.silu(g) * v) @ w_down


def setup_inputs(seed: int = 0) -> dict:
    key = jax.random.key(seed)
    ks = jax.random.split(key, 32)
    f32 = jnp.float32

    def nrm(k, shape, scale):
        return jax.random.normal(k, shape, f32) * scale

    def gain(k, shape):
        return 1.0 + 0.02 * jax.random.normal(k, shape, f32)

    L = DEPTH
    x = jax.random.normal(ks[0], (BATCH, SEQ, D_MODEL), f32)
    mem = jax.random.normal(ks[1], (BATCH, MEM_LEN, D_MODEL), f32)
    mix_norm_w = gain(ks[2], (L, D_MODEL))
    w_in = nrm(ks[3], (L, D_MODEL, IN_COLS), D_MODEL ** -0.5)
    n_idx = jnp.arange(S5_STATE, dtype=f32)
    s5_lambda_re = -0.5 + 0.01 * jax.random.normal(ks[4], (L, S5_GROUPS, S5_STATE), f32)
    s5_lambda_im = math.pi * n_idx + 0.01 * jax.random.normal(ks[5], (L, S5_GROUPS, S5_STATE), f32)
    s5_log_dt = jax.random.uniform(ks[6], (L, S5_GROUPS), f32, math.log(0.001), math.log(0.1))
    s5_b_re = nrm(ks[7], (L, S5_GROUPS, S5_STATE, S5_GROUP_DIM), (2 * S5_GROUP_DIM) ** -0.5)
    s5_b_im = nrm(ks[8], (L, S5_GROUPS, S5_STATE, S5_GROUP_DIM), (2 * S5_GROUP_DIM) ** -0.5)
    s5_c_re = nrm(ks[9], (L, S5_GROUPS, S5_GROUP_DIM, S5_STATE), S5_STATE ** -0.5)
    s5_c_im = nrm(ks[10], (L, S5_GROUPS, S5_GROUP_DIM, S5_STATE), S5_STATE ** -0.5)
    s5_d = nrm(ks[11], (L, S5_WIDTH), 1.0)
    s5_w_glu = nrm(ks[12], (L, S5_WIDTH, S5_WIDTH), S5_WIDTH ** -0.5)
    ssd_conv_w = nrm(ks[13], (L, SSD_CONV, SSD_CONV_DIM), SSD_CONV ** -0.5)
    ssd_conv_b = nrm(ks[14], (L, SSD_CONV_DIM), 0.01)
    dt0 = jnp.exp(jax.random.uniform(ks[15], (L, SSD_HEADS), f32, math.log(0.001), math.log(0.1)))
    ssd_dt_bias = dt0 + jnp.log(-jnp.expm1(-dt0))
    ssd_a_log = jnp.log(jax.random.uniform(ks[16], (L, SSD_HEADS), f32, 1.0, 16.0))
    ssd_d = gain(ks[17], (L, SSD_HEADS))
    ssd_norm_w = gain(ks[18], (L, SSD_INNER))
    w_out = nrm(ks[19], (L, MIX_WIDTH, D_MODEL), MIX_WIDTH ** -0.5)
    xa_norm_w = gain(ks[20], (L, D_MODEL))
    mem_norm_w = gain(ks[21], (L, D_MODEL))
    xa_wq = nrm(ks[22], (L, D_MODEL, D_MODEL), D_MODEL ** -0.5)
    xa_wk = nrm(ks[23], (L, D_MODEL, D_MODEL), D_MODEL ** -0.5)
    xa_wv = nrm(ks[24], (L, D_MODEL, D_MODEL), D_MODEL ** -0.5)
    xa_wo = nrm(ks[25], (L, D_MODEL, D_MODEL), D_MODEL ** -0.5)
    ffn_norm_w = gain(ks[26], (L, D_MODEL))
    ffn_w_up = nrm(ks[27], (L, D_MODEL, 2 * D_FF), D_MODEL ** -0.5)
    ffn_conv_w = nrm(ks[28], (L, FFN_CONV, D_FF), FFN_CONV ** -0.5)
    ffn_conv_b = nrm(ks[29], (L, D_FF), 0.01)
    ffn_w_down = nrm(ks[30], (L, D_FF, D_MODEL), D_FF ** -0.5)
    final_norm_w = gain(ks[31], (D_MODEL,))
    return {"x": x, "mem": mem, "mix_norm_w": mix_norm_w, "w_in": w_in,
            "s5_lambda_re": s5_lambda_re, "s5_lambda_im": s5_lambda_im, "s5_log_dt": s5_log_dt,
            "s5_b_re": s5_b_re, "s5_b_im": s5_b_im, "s5_c_re": s5_c_re, "s5_c_im": s5_c_im,
            "s5_d": s5_d, "s5_w_glu": s5_w_glu,
            "ssd_conv_w": ssd_conv_w, "ssd_conv_b": ssd_conv_b, "ssd_dt_bias": ssd_dt_bias,
            "ssd_a_log": ssd_a_log, "ssd_d": ssd_d, "ssd_norm_w": ssd_norm_w, "w_out": w_out,
            "xa_norm_w": xa_norm_w, "mem_norm_w": mem_norm_w, "xa_wq": xa_wq, "xa_wk": xa_wk,
            "xa_wv": xa_wv, "xa_wo": xa_wo, "ffn_norm_w": ffn_norm_w, "ffn_w_up": ffn_w_up,
            "ffn_conv_w": ffn_conv_w, "ffn_conv_b": ffn_conv_b, "ffn_w_down": ffn_w_down,
            "final_norm_w": final_norm_w}


def reference(x, mem, mix_norm_w, w_in, s5_lambda_re, s5_lambda_im, s5_log_dt, s5_b_re, s5_b_im,
              s5_c_re, s5_c_im, s5_d, s5_w_glu, ssd_conv_w, ssd_conv_b, ssd_dt_bias, ssd_a_log,
              ssd_d, ssd_norm_w, w_out, xa_norm_w, mem_norm_w, xa_wq, xa_wk, xa_wv, xa_wo,
              ffn_norm_w, ffn_w_up, ffn_conv_w, ffn_conv_b, ffn_w_down, final_norm_w):
    c_u = S5_WIDTH
    c_z = c_u + SSD_INNER
    c_xbc = c_z + SSD_CONV_DIM
    for i in range(DEPTH):
        h = rmsnorm(x, mix_norm_w[i])
        proj = h @ w_in[i]
        y_s5 = s5_mixer(proj[..., :c_u], s5_lambda_re[i], s5_lambda_im[i], s5_log_dt[i],
                        s5_b_re[i], s5_b_im[i], s5_c_re[i], s5_c_im[i], s5_d[i], s5_w_glu[i])
        y_ssd = ssd_mixer(proj[..., c_u:c_z], proj[..., c_z:c_xbc], proj[..., c_xbc:],
                          ssd_conv_w[i], ssd_conv_b[i], ssd_dt_bias[i], ssd_a_log[i],
                          ssd_d[i], ssd_norm_w[i])
        x = x + jnp.concatenate([y_s5, y_ssd], axis=-1) @ w_out[i]
        h = rmsnorm(x, xa_norm_w[i])
        mem_n = rmsnorm(mem, mem_norm_w[i])
        x = x + cross_attention(h, mem_n, xa_wq[i], xa_wk[i], xa_wv[i], xa_wo[i])
        h = rmsnorm(x, ffn_norm_w[i])
        x = x + conv_ffn(h, ffn_w_up[i], ffn_conv_w[i], ffn_conv_b[i], ffn_w_down[i])
    return rmsnorm(x, final_norm_w)
```

```cpp
#include <hip/hip_runtime.h>
#include <hip/hip_cooperative_groups.h>
#include <cstdio>
#include <cstdint>
namespace cg = cooperative_groups;

#define LAS __attribute__((address_space(3)))
typedef unsigned short bf16_t;
typedef short bf16x8 __attribute__((ext_vector_type(8)));
typedef float f32x4 __attribute__((ext_vector_type(4)));
typedef float f32x2 __attribute__((ext_vector_type(2)));
typedef unsigned u32x4 __attribute__((ext_vector_type(4)));
typedef unsigned u32x2 __attribute__((ext_vector_type(2)));

#define PROBE_DUPM 0
#define PROBE_SYNC2 0
constexpr int T = 32768, D = 1024, SEQ = 16384, NL = 4, INC = 2828, PLD = 2816, DFF = 2816;
constexpr float EPS = 1e-6f;
constexpr size_t MiB = 1u << 20;
constexpr size_t WS_WIN = 1 * MiB, WS_WOUT = 7 * MiB, WS_WQK = 9 * MiB, WS_WVO = 13 * MiB, WS_WUP = 17 * MiB, WS_WDOWN = 28 * MiB, WS_WGLU = 34 * MiB,
                 WS_S5A = 35 * MiB, WS_S5B = 47 * MiB, WS_WQS = 51 * MiB, WS_WKT = 53 * MiB, WS_WVT = 55 * MiB, WS_WOT = 57 * MiB, WS_MEMN = 59 * MiB,
                 WS_KB = 60 * MiB, WS_VB = 61 * MiB, WS_SSQ = 62 * MiB, WS_XB = 64 * MiB,
                 WS_PROJ = 128 * MiB, WS_YCAT = 304 * MiB, WS_ST = 368 * MiB, WS_YPRE = 416 * MiB, WS_YG = 432 * MiB, WS_HLOC = 448 * MiB, WS_HPREV = 456 * MiB,
                 WS_DT = 464 * MiB, WS_CD = 466 * MiB, WS_RSD = 467 * MiB, WS_WQKA = 468 * MiB, WS_WVOA = 484 * MiB, WS_END = 500 * MiB, WS_TMP = 128 * MiB, TMP_L = 11 * MiB,
                 WS_P = 128 * MiB, WS_ACT = 192 * MiB, WS_GF = 368 * MiB, WS_VF = 380 * MiB, WS_GL = 392 * MiB;
constexpr int LDS_BYTES = 147456 + 256, RING_BYTES = 131072, SPARE_OFF = 131072, MISC_OFF = 147456;

__device__ __forceinline__ unsigned cvt_pk_bf16(float lo, float hi) { unsigned r; asm volatile("v_cvt_pk_bf16_f32 %0, %1, %2" : "=v"(r) : "v"(lo), "v"(hi)); return r; }
__device__ __forceinline__ float bflo(unsigned u) { return __uint_as_float(u << 16); }
__device__ __forceinline__ float bfhi(unsigned u) { return __uint_as_float(u & 0xffff0000u); }
__device__ __forceinline__ float bf1(bf16_t b) { return __uint_as_float(((unsigned)b) << 16); }
__device__ __forceinline__ float silu_f(float x) { return x * __builtin_amdgcn_rcpf(1.f + __expf(-x)); }
__device__ __forceinline__ float sigmoid_f(float x) { return __builtin_amdgcn_rcpf(1.f + __expf(-x)); }
__device__ __forceinline__ float gelu_tanh(float x) { const float u = 0.7978845608028654f * (x + 0.044715f * x * x * x); const float t = 1.f - 2.f * __builtin_amdgcn_rcpf(1.f + __expf(2.f * u)); return 0.5f * x * (1.f + t); }
__device__ __forceinline__ void sincos_rev(float theta, float& sn, float& cs) { float r = theta * 0.15915494309189535f; r -= floorf(r); sn = __builtin_amdgcn_sinf(r); cs = __builtin_amdgcn_cosf(r); }
__device__ __forceinline__ float softplus_f(float x) { const float e = __expf(x); const float sp = (e < 0.02f) ? e * (1.f - e * (0.5f - e * 0.33333334f)) : __logf(1.f + e); return x > 20.f ? x : sp; }
__device__ __forceinline__ float wave_sum(float v) {
#pragma unroll
    for (int o = 1; o < 64; o <<= 1) v += __shfl_xor(v, o);
    return v;
}
__device__ __forceinline__ float dpp_prev1(float g0, float prev) {
    const int o = __builtin_amdgcn_update_dpp(0, __float_as_int(prev), 0x10F, 0xf, 0xf, true);
    return __int_as_float(__builtin_amdgcn_update_dpp(o, __float_as_int(g0), 0x111, 0xf, 0xf, false));
}
__device__ __forceinline__ float dpp_prev2(float g0, float prev) {
    const int o = __builtin_amdgcn_update_dpp(0, __float_as_int(prev), 0x10E, 0xf, 0xf, true);
    return __int_as_float(__builtin_amdgcn_update_dpp(o, __float_as_int(g0), 0x112, 0xf, 0xf, false));
}

#ifndef SP2
#define SP2 1
#endif
constexpr int BM = 256, BK = 64, HALF = 128, HTB = HALF * BK * 2;
__device__ __forceinline__ int lds_byte(int r, int c) { const int st = (r >> 4) * 2 + (c >> 5), rr = r & 15, cc = c & 31, ob = rr * 64 + cc * 2; return st * 1024 + (ob ^ (((ob >> 9) & 1) << 5)); }
__device__ __forceinline__ void stage_rc(int b, int& R, int& C) { const int st = b / 1024, sb = b % 1024, swz = sb ^ (((sb >> 9) & 1) << 5); R = (st >> 1) * 16 + swz / 64; C = (st & 1) * 32 + (swz % 64) / 2; }
__device__ __forceinline__ int perm32(int rho) { const int n = rho >> 4, i = rho & 15; return 8 * (i >> 2) + 4 * n + (i & 3); }

struct Unit { const char* A; const char* B; bf16_t* O; int pm, pn, z; };
template <int MODE, int LDA, int LDB, int NT, int NM, int NN, int NWG> struct GS {
    static constexpr int nt = NT, ldb = LDB;
    int G, c;
    const char* A; const char* B; size_t bstride; bf16_t* O; const char* A2; const char* B2; bf16_t* O2;
    __device__ __forceinline__ int a_off(int R, int C) const { return MODE == 1 ? (R * 32 + (C >> 4)) * PLD + (C & 15) : R * LDA + C; }
    __device__ __forceinline__ size_t a_kstep() const { return MODE == 1 ? (size_t)4 * PLD * 2 : (size_t)128; }
    __device__ __forceinline__ size_t a_hstep() const { return MODE == 1 ? (size_t)128 * 32 * PLD * 2 : (size_t)128 * LDA * 2; }
    __device__ __forceinline__ bool next(int i, Unit& u) const {
        const int L = i * G + c; if (L >= NWG) return false;
        u.O = nullptr; u.z = 0;
        if constexpr (MODE == 0) {
            int wgid = L; { constexpr int q = NWG / 8, r = NWG % 8; const int xcd = wgid % 8, off = wgid / 8; wgid = (xcd < r ? xcd * (q + 1) : r * (q + 1) + (xcd - r) * q) + off; }
            constexpr int nig = 8 * NN; const int gid = wgid / nig, fm = gid * 8, gsz = (NM - fm) < 8 ? (NM - fm) : 8;
            u.pm = fm + ((wgid % nig) % gsz); u.pn = (wgid % nig) / gsz;
            u.A = A + (size_t)u.pm * 256 * LDA * 2; u.B = B + (size_t)(u.pm >> 6) * bstride + (size_t)u.pn * 256 * LDB * 2;
        } else if constexpr (MODE == 1) {
            const int g = L / 12, r = L % 12; u.pm = r & 3; u.pn = r >> 2; u.z = g;
            u.A = A + ((size_t)u.pm * 256 * 32 * PLD + 16 * g) * 2; u.B = B + ((size_t)g * 768 + u.pn * 256) * 512 * 2;
        } else if constexpr (MODE == 2) {
            const int g = L >> 3, r = L & 7; u.pm = r & 3; u.pn = r >> 2; u.z = g;
            u.A = A + ((size_t)u.pm * 256 * 16 + g) * 256 * 2; u.B = B + ((size_t)g * 512 + u.pn * 256) * 256 * 2;
        } else if constexpr (MODE == 3) {
            const int lay = L >> 4, which = (L >> 3) & 1, pm = (L >> 2) & 1, pn = L & 3; const char* tb = A + WS_TMP + (size_t)lay * TMP_L;
            u.A = tb + 8 * MiB + (size_t)pm * 256 * 1024 * 2; u.B = tb + (which ? 4 : 2) * MiB + (size_t)pn * 256 * 1024 * 2; u.O = (bf16_t*)(tb + (which ? 10 : 9) * MiB) + (size_t)pm * 256 * 1024 + pn * 256;
            u.pm = 0; u.pn = 0;
        } else {
            const int lay = L >> 6, l6 = L & 63, l5 = l6 & 31, b = l5 >> 4, h = (l5 >> 2) & 3, p = l5 & 3; const char* tb = A + WS_TMP + (size_t)lay * TMP_L;
            if (l6 < 32) { u.A = tb + 9 * MiB + ((size_t)b * 256 * 1024 + 256 * h) * 2; u.B = tb + ((size_t)p * 256 * 1024 + 256 * h) * 2;
                           u.O = (bf16_t*)(A + WS_WQKA) + (size_t)(lay * 2 + b) * 1024 * 1024 + (size_t)(256 * h) * 1024 + 256 * p; }
            else { u.A = tb + 6 * MiB + ((size_t)p * 256 * 1024 + 256 * h) * 2; u.B = tb + 10 * MiB + ((size_t)b * 256 * 1024 + 256 * h) * 2;
                   u.O = (bf16_t*)(A + WS_WVOA) + (size_t)(lay * 2 + b) * 1024 * 1024 + (size_t)(256 * p) * 1024 + 256 * h; }
            u.pm = 0; u.pn = 0;
        }
        return true;
    }
};

typedef f32x4 AccT[2][2][4][2];

template <class Epi, class GSched>
__device__ __forceinline__ void gemm_phase(LAS unsigned char* lds, const int tid, const GSched& S, const Epi& E) {
    const int wid = __builtin_amdgcn_readfirstlane(tid >> 6), lane = tid & 63, wr = wid >> 2, wc = wid & 3, fr = lane & 15, fq = lane >> 4;
    constexpr int nt = GSched::nt;
    unsigned voffA[2], voffB[2];
#pragma unroll
    for (int i = 0; i < 2; ++i) { int R, C; stage_rc(tid * 16 + i * 8192, R, C); const int Rb = (R & ~31) + perm32(R & 31);
        voffA[i] = (unsigned)S.a_off(R, C) * 2u; voffB[i] = (unsigned)(Rb * GSched::ldb + C) * 2u; }
    const size_t kstepA = S.a_kstep(), hstepA = S.a_hstep(), kstepB = 128, hstepB = (size_t)HALF * GSched::ldb * 2;
    const unsigned ldsw = (unsigned)wid * 1024u;
    const int aoff = lds_byte(wr * 64 + fr, fq * 8), boff = lds_byte(wc * 32 + fr, fq * 8);
#define PG8_SA(b, h) (((b) * 2 + (h)) * HTB)
#define PG8_SB(b, h) ((4 + (b) * 2 + (h)) * HTB)
#define PG8_STAGE(bufoff, gbase, voff) do { _Pragma("unroll") for (int _i = 0; _i < 2; ++_i) { unsigned _vo = (voff)[_i]; asm volatile("" : "+v"(_vo)); \
        __builtin_amdgcn_global_load_lds((const unsigned*)((const char*)(gbase) + _vo), (LAS unsigned*)(lds + (bufoff) + ldsw + _i * 8192), 16, 0, 0); } } while (0)
#define PG8_LDA(dst, b, h) do { _Pragma("unroll") for (int m = 0; m < 4; ++m) _Pragma("unroll") for (int k = 0; k < 2; ++k) dst[m][k] = *(const LAS bf16x8*)(lds + PG8_SA(b, h) + aoff + m * 2048 + k * 1024); } while (0)
#define PG8_LDB(dst, b, h) do { _Pragma("unroll") for (int n = 0; n < 2; ++n) _Pragma("unroll") for (int k = 0; k < 2; ++k) dst[n][k] = *(const LAS bf16x8*)(lds + PG8_SB(b, h) + boff + n * 2048 + k * 1024); } while (0)
#define PG8_MMA(ai, bj, At, Bt) do { __builtin_amdgcn_s_setprio(1); _Pragma("unroll") for (int m = 0; m < 4; ++m) _Pragma("unroll") for (int n = 0; n < 2; ++n) _Pragma("unroll") for (int k = 0; k < 2; ++k) \
        acc[ai][bj][m][n] = __builtin_amdgcn_mfma_f32_16x16x32_bf16(Bt[n][k], At[m][k], acc[ai][bj][m][n], 0, 0, 0); __builtin_amdgcn_s_setprio(0); } while (0)
#define PG8_WAIT_V(n) asm volatile("s_waitcnt vmcnt(" #n ")" ::: "memory")
#define PG8_WAIT_L(n) asm volatile("s_waitcnt lgkmcnt(" #n ")" ::: "memory")
#define PG8_BAR __builtin_amdgcn_s_barrier()
#define PG8_SCHED __builtin_amdgcn_sched_barrier(0)
    Unit cur, nxt; int ui = 0;
    if (!S.next(0, cur)) return;
    AccT acc;
    { float zz; asm volatile("v_mov_b32 %0, 0" : "=v"(zz));
#pragma unroll
    for (int a = 0; a < 2; ++a)
#pragma unroll
        for (int b = 0; b < 2; ++b)
#pragma unroll
            for (int m = 0; m < 4; ++m)
#pragma unroll
                for (int n = 0; n < 2; ++n) acc[a][b][m][n] = (f32x4){zz, zz, zz, zz}; }
    bf16x8 At[4][2], B0[2][2], B1[2][2];
    const char* cA = cur.A; const char* cB = cur.B;
#if SP2
    PG8_STAGE(PG8_SB(0, 0), cB, voffB); PG8_STAGE(PG8_SB(0, 1), cB + hstepB, voffB); PG8_STAGE(PG8_SA(0, 0), cA, voffA); PG8_STAGE(PG8_SA(0, 1), cA + hstepA, voffA);
    if (wr == 1) PG8_BAR;
    PG8_WAIT_V(2); PG8_BAR;
    PG8_STAGE(PG8_SB(1, 0), cB + kstepB, voffB); PG8_STAGE(PG8_SA(1, 0), cA + kstepA, voffA); PG8_STAGE(PG8_SB(1, 1), cB + hstepB + kstepB, voffB);
    PG8_WAIT_V(6); PG8_BAR;
#else
    PG8_STAGE(PG8_SB(0, 0), cB, voffB); PG8_STAGE(PG8_SA(0, 0), cA, voffA); PG8_STAGE(PG8_SB(0, 1), cB + hstepB, voffB); PG8_STAGE(PG8_SA(0, 1), cA + hstepA, voffA);
    if (wr == 1) PG8_BAR;
    PG8_WAIT_V(4); PG8_BAR;
    PG8_STAGE(PG8_SB(1, 0), cB + kstepB, voffB); PG8_STAGE(PG8_SA(1, 0), cA + kstepA, voffA); PG8_STAGE(PG8_SB(1, 1), cB + hstepB + kstepB, voffB);
    PG8_WAIT_V(6); PG8_BAR;
#endif
    for (;;) {
        const bool has_next = S.next(ui + 1, nxt);
        const char* nA = has_next ? nxt.A : cA; const char* nB = has_next ? nxt.B : cB;
        for (int t = 0; t < nt; t += 2) {
            const bool last = (t == nt - 2);
            const char* a1 = cA + (size_t)(t + 1) * kstepA;
            const char* a2 = last ? nA : cA + (size_t)(t + 2) * kstepA; const char* b2 = last ? nB : cB + (size_t)(t + 2) * kstepB;
            const char* a3 = a2 + kstepA; const char* b3 = b2 + kstepB;
#if SP2
            PG8_LDB(B0, 0, 0); PG8_LDB(B1, 0, 1); PG8_SCHED; PG8_LDA(At, 0, 0); PG8_STAGE(PG8_SA(1, 1), a1 + hstepA, voffA);
            PG8_WAIT_V(8); PG8_WAIT_L(0); PG8_BAR; PG8_MMA(0, 0, At, B0); PG8_MMA(0, 1, At, B1); PG8_BAR; PG8_SCHED;
            PG8_LDA(At, 0, 1); PG8_STAGE(PG8_SB(0, 0), b2, voffB); PG8_STAGE(PG8_SB(0, 1), b2 + hstepB, voffB); PG8_STAGE(PG8_SA(0, 0), a2, voffA);
            PG8_WAIT_V(8); PG8_WAIT_L(0); PG8_BAR; PG8_MMA(1, 0, At, B0); PG8_MMA(1, 1, At, B1); PG8_BAR; PG8_SCHED;
            PG8_LDB(B0, 1, 0); PG8_LDB(B1, 1, 1); PG8_SCHED; PG8_LDA(At, 1, 0); PG8_STAGE(PG8_SA(0, 1), a2 + hstepA, voffA);
            PG8_WAIT_V(8); PG8_WAIT_L(0); PG8_BAR; PG8_MMA(0, 0, At, B0); PG8_MMA(0, 1, At, B1); PG8_BAR; PG8_SCHED;
            PG8_LDA(At, 1, 1); PG8_STAGE(PG8_SB(1, 0), b3, voffB); PG8_STAGE(PG8_SB(1, 1), b3 + hstepB, voffB); PG8_STAGE(PG8_SA(1, 0), a3, voffA);
            PG8_WAIT_V(8); PG8_WAIT_L(0); PG8_BAR; PG8_MMA(1, 0, At, B0); PG8_MMA(1, 1, At, B1); PG8_BAR; PG8_SCHED;
#else
            PG8_LDB(B0, 0, 0); PG8_SCHED; PG8_LDA(At, 0, 0); PG8_STAGE(PG8_SA(1, 1), a1 + hstepA, voffA);
            PG8_WAIT_L(8); PG8_BAR; PG8_WAIT_L(0); PG8_MMA(0, 0, At, B0); PG8_BAR; PG8_SCHED;
            PG8_LDB(B1, 0, 1); PG8_STAGE(PG8_SB(0, 0), b2, voffB);
            PG8_BAR; PG8_WAIT_L(0); PG8_MMA(0, 1, At, B1); PG8_BAR;
            PG8_LDA(At, 0, 1); PG8_STAGE(PG8_SA(0, 0), a2, voffA);
            PG8_BAR; PG8_WAIT_L(0); PG8_MMA(1, 0, At, B0); PG8_BAR; PG8_SCHED;
            PG8_STAGE(PG8_SB(0, 1), b2 + hstepB, voffB);
            PG8_WAIT_V(6); PG8_BAR; PG8_MMA(1, 1, At, B1); PG8_BAR;
            PG8_LDB(B0, 1, 0); PG8_SCHED; PG8_LDA(At, 1, 0); PG8_STAGE(PG8_SA(0, 1), a2 + hstepA, voffA);
            PG8_WAIT_L(8); PG8_BAR; PG8_WAIT_L(0); PG8_MMA(0, 0, At, B0); PG8_BAR; PG8_SCHED;
            PG8_LDB(B1, 1, 1); PG8_STAGE(PG8_SB(1, 0), b3, voffB);
            PG8_BAR; PG8_WAIT_L(0); PG8_MMA(0, 1, At, B1); PG8_BAR;
            PG8_LDA(At, 1, 1); PG8_STAGE(PG8_SA(1, 0), a3, voffA);
            PG8_BAR; PG8_WAIT_L(0); PG8_MMA(1, 0, At, B0); PG8_BAR; PG8_SCHED;
            PG8_STAGE(PG8_SB(1, 1), b3 + hstepB, voffB);
            PG8_WAIT_V(6); PG8_BAR; PG8_MMA(1, 1, At, B1); PG8_BAR;
#endif
        }
        if (wr == 0) PG8_BAR;
        { int ln_; asm volatile("v_mbcnt_lo_u32_b32 %0, -1, 0\n\tv_mbcnt_hi_u32_b32 %0, -1, %0" : "=v"(ln_)); E(acc, cur, lds, wr, wc, ln_ & 15, ln_ >> 4); }
        if (!has_next) break;
        { float zz; asm volatile("v_mov_b32 %0, 0" : "=v"(zz));
#pragma unroll
        for (int a = 0; a < 2; ++a)
#pragma unroll
            for (int b = 0; b < 2; ++b)
#pragma unroll
                for (int m = 0; m < 4; ++m)
#pragma unroll
                    for (int n = 0; n < 2; ++n) acc[a][b][m][n] = (f32x4){zz, zz, zz, zz}; }
        cur = nxt; cA = nA; cB = nB; ++ui;
        if (wr == 1) PG8_BAR;
    }
    PG8_WAIT_V(0);
    PG8_BAR;
#undef PG8_SA
#undef PG8_SB
#undef PG8_STAGE
#undef PG8_LDA
#undef PG8_LDB
#undef PG8_MMA
#undef PG8_WAIT_V
#undef PG8_WAIT_L
#undef PG8_BAR
#undef PG8_SCHED
}

#define EROW(ai, m) (128 * (ai) + 64 * wr + 16 * (m) + fr)
#define ECOL(bj) (128 * (bj) + 32 * wc + 8 * fq)
__device__ __forceinline__ float row_rs(const float* ssq, int row, int fq) {
    const f32x4 v = *(const f32x4*)(ssq + (size_t)row * 16 + 4 * fq); float s = (v.x + v.y) + (v.z + v.w);
    s += __shfl_xor(s, 16); s += __shfl_xor(s, 32);
    return rsqrtf(s * (1.f / 1024.f) + EPS);
}
__device__ __forceinline__ u32x4 pack8(const f32x4 a, const f32x4 b) { u32x4 w; w.x = cvt_pk_bf16(a[0], a[1]); w.y = cvt_pk_bf16(a[2], a[3]); w.z = cvt_pk_bf16(b[0], b[1]); w.w = cvt_pk_bf16(b[2], b[3]); return w; }

struct EpiStore { int ldc;
    __device__ __forceinline__ void operator()(AccT& acc, const Unit& u, LAS unsigned char*, int wr, int wc, int fr, int fq) const {
#pragma unroll
        for (int ai = 0; ai < 2; ++ai)
#pragma unroll
            for (int m = 0; m < 4; ++m) { bf16_t* rp = u.O + (size_t)EROW(ai, m) * ldc;
#pragma unroll
                for (int bj = 0; bj < 2; ++bj) *(u32x4*)(rp + ECOL(bj)) = pack8(acc[ai][bj][m][0], acc[ai][bj][m][1]); }
    }
};
struct EpiProj { bf16_t* proj; float* dt; const float* ssq;
    __device__ __forceinline__ void operator()(AccT& acc, const Unit& u, LAS unsigned char*, int wr, int wc, int fr, int fq) const {
#pragma unroll
        for (int ai = 0; ai < 2; ++ai)
#pragma unroll
            for (int m = 0; m < 4; ++m) { const int row = u.pm * 256 + EROW(ai, m); const float rs = row_rs(ssq, row, fq);
                if (u.pn < 11) {
#pragma unroll
                    for (int bj = 0; bj < 2; ++bj) *(u32x4*)(proj + (size_t)row * PLD + u.pn * 256 + ECOL(bj)) = pack8(acc[ai][bj][m][0] * rs, acc[ai][bj][m][1] * rs);
                } else if (wc == 0 && fq < 2) {
                    *(f32x4*)(dt + (size_t)row * 16 + 8 * fq) = acc[ai][0][m][0] * rs; *(f32x4*)(dt + (size_t)row * 16 + 8 * fq + 4) = acc[ai][0][m][1] * rs;
                } }
    }
};
struct EpiRes { bf16_t* xb; float* ssq; const float* rsd;
    __device__ __forceinline__ void operator()(AccT& acc, const Unit& u, LAS unsigned char*, int wr, int wc, int fr, int fq) const {
#pragma unroll
        for (int ai = 0; ai < 2; ++ai)
#pragma unroll
            for (int m = 0; m < 4; ++m) { const int row = u.pm * 256 + EROW(ai, m); float s = 0.f; const float rsc = rsd ? rsd[(size_t)row * 2] : 1.f;
#pragma unroll
                for (int bj = 0; bj < 2; ++bj) { const size_t off = (size_t)row * D + u.pn * 256 + ECOL(bj); acc[ai][bj][m][0] *= rsc; acc[ai][bj][m][1] *= rsc;
                    const u32x4 xo = *(const u32x4*)(xb + off);
                    const f32x4 a = (f32x4){bflo(xo.x), bfhi(xo.x), bflo(xo.y), bfhi(xo.y)} + acc[ai][bj][m][0], b = (f32x4){bflo(xo.z), bfhi(xo.z), bflo(xo.w), bfhi(xo.w)} + acc[ai][bj][m][1];
                    *(u32x4*)(xb + off) = pack8(a, b);
                    s += (a[0] * a[0] + a[1] * a[1]) + (a[2] * a[2] + a[3] * a[3]) + (b[0] * b[0] + b[1] * b[1]) + (b[2] * b[2] + b[3] * b[3]); }
                s += __shfl_xor(s, 16); s += __shfl_xor(s, 32);
                if (fq == 0) ssq[(size_t)row * 16 + u.pn * 4 + wc] = s; }
    }
};
struct EpiSoftmax { bf16_t* P; const float* ssq;
    __device__ __forceinline__ void operator()(AccT& acc, const Unit& u, LAS unsigned char* lds, int wr, int wc, int fr, int fq) const {
        LAS f32x2* tab = (LAS f32x2*)(lds + SPARE_OFF);
        float mown[2][4];
#pragma unroll
        for (int ai = 0; ai < 2; ++ai)
#pragma unroll
            for (int m = 0; m < 4; ++m) { const int rl = EROW(ai, m); const float rs = row_rs(ssq, u.pm * 256 + rl, fq); float mx = -3.0e38f;
#pragma unroll
                for (int bj = 0; bj < 2; ++bj)
#pragma unroll
                    for (int n = 0; n < 2; ++n) { acc[ai][bj][m][n] *= rs; const f32x4 v = acc[ai][bj][m][n]; mx = fmaxf(mx, fmaxf(fmaxf(v[0], v[1]), fmaxf(v[2], v[3]))); }
                mx = fmaxf(mx, __shfl_xor(mx, 16)); mx = fmaxf(mx, __shfl_xor(mx, 32)); float l = 0.f;
#pragma unroll
                for (int bj = 0; bj < 2; ++bj)
#pragma unroll
                    for (int n = 0; n < 2; ++n) { f32x4 v = acc[ai][bj][m][n]; v[0] = __expf(v[0] - mx); v[1] = __expf(v[1] - mx); v[2] = __expf(v[2] - mx); v[3] = __expf(v[3] - mx); acc[ai][bj][m][n] = v; l += (v[0] + v[1]) + (v[2] + v[3]); }
                l += __shfl_xor(l, 16); l += __shfl_xor(l, 32); mown[ai][m] = mx;
                if (fq == 0) tab[rl * 4 + wc] = (f32x2){mx, l}; }
        asm volatile("s_waitcnt lgkmcnt(0)" ::: "memory"); __builtin_amdgcn_s_barrier(); asm volatile("" ::: "memory");
#pragma unroll
        for (int ai = 0; ai < 2; ++ai)
#pragma unroll
            for (int m = 0; m < 4; ++m) { const int rl = EROW(ai, m); const f32x2 t0 = tab[rl * 4 + 0], t1 = tab[rl * 4 + 1], t2 = tab[rl * 4 + 2], t3 = tab[rl * 4 + 3];
                const float M = fmaxf(fmaxf(t0.x, t1.x), fmaxf(t2.x, t3.x));
                const float Lsum = t0.y * __expf(t0.x - M) + t1.y * __expf(t1.x - M) + t2.y * __expf(t2.x - M) + t3.y * __expf(t3.x - M);
                const float f = __expf(mown[ai][m] - M) / Lsum;
                bf16_t* rp = P + (size_t)(u.pm * 256 + rl) * D + u.pn * 256;
#pragma unroll
                for (int bj = 0; bj < 2; ++bj) *(u32x4*)(rp + ECOL(bj)) = pack8(acc[ai][bj][m][0] * f, acc[ai][bj][m][1] * f); }
        asm volatile("s_waitcnt lgkmcnt(0)" ::: "memory"); __builtin_amdgcn_s_barrier(); asm volatile("" ::: "memory");
    }
};
struct EpiUp { bf16_t* act; float* gf; float* vf; float* gl; const float* ssq; const float* cw; const float* cb;
    __device__ __forceinline__ void operator()(AccT& acc, const Unit& u, LAS unsigned char*, int wr, int wc, int fr, int fq) const {
        const int ch = u.pn * 128 + 32 * wc + 8 * fq;
        f32x4 w0[2], w1[2], w2[2], bb[2];
#pragma unroll
        for (int n = 0; n < 2; ++n) { w0[n] = *(const f32x4*)(cw + ch + 4 * n); w1[n] = *(const f32x4*)(cw + DFF + ch + 4 * n); w2[n] = *(const f32x4*)(cw + 2 * DFF + ch + 4 * n); bb[n] = *(const f32x4*)(cb + ch + 4 * n); }
#pragma unroll
        for (int ai = 0; ai < 2; ++ai) {
            float rs[4];
#pragma unroll
            for (int m = 0; m < 4; ++m) rs[m] = row_rs(ssq, u.pm * 256 + EROW(ai, m), fq);
#pragma unroll
            for (int m = 0; m < 4; ++m)
#pragma unroll
                for (int n = 0; n < 2; ++n) { acc[ai][0][m][n] *= rs[m]; acc[ai][1][m][n] *= rs[m]; }
            const int q = u.pm * 4 + ai * 2 + wr;
#pragma unroll
            for (int m = 0; m < 4; ++m) { const int row = u.pm * 256 + EROW(ai, m);
                f32x4 o[2];
#pragma unroll
                for (int n = 0; n < 2; ++n)
#pragma unroll
                    for (int j = 0; j < 4; ++j) { const float g0 = acc[ai][0][m][n][j]; const float pv = (m > 0) ? acc[ai][0][m > 0 ? m - 1 : 0][n][j] : 0.f;
                        const float g1 = dpp_prev1(g0, pv), g2 = dpp_prev2(g0, pv);
                        const float gc = __builtin_fmaf(w0[n][j], g2, __builtin_fmaf(w1[n][j], g1, __builtin_fmaf(w2[n][j], g0, bb[n][j])));
                        o[n][j] = silu_f(gc) * acc[ai][1][m][n][j]; }
                if (m == 0 && fr < 2) {
                    const size_t so = ((size_t)q * 2 + fr) * DFF + ch;
                    *(f32x4*)(gf + so) = acc[ai][0][0][0]; *(f32x4*)(gf + so + 4) = acc[ai][0][0][1];
                    *(f32x4*)(vf + so) = acc[ai][1][0][0]; *(f32x4*)(vf + so + 4) = acc[ai][1][0][1];
                } else {
                    *(u32x4*)(act + (size_t)row * DFF + ch) = pack8(o[0], o[1]);
                }
                if (m == 3 && fr >= 14) { const size_t so = ((size_t)q * 2 + (fr - 14)) * DFF + ch;
                    *(f32x4*)(gl + so) = acc[ai][0][3][0]; *(f32x4*)(gl + so + 4) = acc[ai][0][3][1]; }
            }
        }
    }
};
struct EpiS5A { bf16_t* ypre; float* hloc;
    __device__ __forceinline__ void operator()(AccT& acc, const Unit& u, LAS unsigned char*, int wr, int wc, int fr, int fq) const {
        const int g = u.z;
#pragma unroll
        for (int ai = 0; ai < 2; ++ai)
#pragma unroll
            for (int m = 0; m < 4; ++m) { const int chunk = u.pm * 256 + EROW(ai, m);
                if (u.pn < 2) {
#pragma unroll
                    for (int bj = 0; bj < 2; ++bj) { const int qc = u.pn * 256 + ECOL(bj), t = qc >> 4, c = qc & 15;
                        *(u32x4*)(ypre + ((size_t)chunk * 32 + t) * 256 + 16 * g + c) = pack8(acc[ai][bj][m][0], acc[ai][bj][m][1]); }
                } else {
                    float* hp = hloc + ((size_t)chunk * 16 + g) * 128 + ECOL(0);
                    *(f32x4*)hp = acc[ai][0][m][0]; *(f32x4*)(hp + 4) = acc[ai][0][m][1];
                } }
    }
};
struct EpiS5B { const bf16_t* ypre; bf16_t* yg;
    __device__ __forceinline__ void operator()(AccT& acc, const Unit& u, LAS unsigned char*, int wr, int wc, int fr, int fq) const {
        const int g = u.z;
#pragma unroll
        for (int ai = 0; ai < 2; ++ai)
#pragma unroll
            for (int m = 0; m < 4; ++m) { const int chunk = u.pm * 256 + EROW(ai, m);
#pragma unroll
                for (int bj = 0; bj < 2; ++bj) { const int qc = u.pn * 256 + ECOL(bj), t = qc >> 4, c = qc & 15; const size_t off = ((size_t)chunk * 32 + t) * 256 + 16 * g + c;
                    const u32x4 p = *(const u32x4*)(ypre + off); f32x4 a = acc[ai][bj][m][0], b = acc[ai][bj][m][1];
                    a[0] = gelu_tanh(a[0] + bflo(p.x)); a[1] = gelu_tanh(a[1] + bfhi(p.x)); a[2] = gelu_tanh(a[2] + bflo(p.y)); a[3] = gelu_tanh(a[3] + bfhi(p.y));
                    b[0] = gelu_tanh(b[0] + bflo(p.z)); b[1] = gelu_tanh(b[1] + bfhi(p.z)); b[2] = gelu_tanh(b[2] + bflo(p.w)); b[3] = gelu_tanh(b[3] + bfhi(p.w));
                    *(u32x4*)(yg + off) = pack8(a, b); } }
    }
};
struct EpiGlu { const bf16_t* yg; bf16_t* ycat; const float* rsd;
    __device__ __forceinline__ void operator()(AccT& acc, const Unit& u, LAS unsigned char*, int wr, int wc, int fr, int fq) const {
#pragma unroll
        for (int ai = 0; ai < 2; ++ai)
#pragma unroll
            for (int m = 0; m < 4; ++m) { const int row = u.pm * 256 + EROW(ai, m); const float irs = rsd[(size_t)row * 2 + 1];
#pragma unroll
                for (int bj = 0; bj < 2; ++bj) { const int c = ECOL(bj); const u32x4 p = *(const u32x4*)(yg + (size_t)row * 256 + c); f32x4 a = acc[ai][bj][m][0], b = acc[ai][bj][m][1];
                    a[0] = bflo(p.x) * sigmoid_f(a[0]); a[1] = bfhi(p.x) * sigmoid_f(a[1]); a[2] = bflo(p.y) * sigmoid_f(a[2]); a[3] = bfhi(p.y) * sigmoid_f(a[3]);
                    b[0] = bflo(p.z) * sigmoid_f(b[0]); b[1] = bfhi(p.z) * sigmoid_f(b[1]); b[2] = bflo(p.w) * sigmoid_f(b[2]); b[3] = bfhi(p.w) * sigmoid_f(b[3]);
                    *(u32x4*)(ycat + (size_t)row * D + c) = pack8(a * irs, b * irs); } }
    }
};

struct Args { const float* in[32]; float* out; unsigned char* ws; int dupm; int sync2; };
typedef const Args __attribute__((address_space(4))) CArgs;
struct Frame { LAS unsigned char* lds; int tid, lane, wave, G, wg; unsigned char* ws; float* out; };

__device__ __forceinline__ void tr_item(const float* W, int K, int N, bf16_t* WT, const float* kscale, int upmap, LAS float* scr, int item, int nblk, int lane) {
    const int kb = item / nblk, nb = item % nblk, k0 = 64 * kb, n0 = 32 * nb;
    const int c4 = (lane & 7) * 4, rr = lane >> 3;
    f32x4 v[8];
#pragma unroll
    for (int i = 0; i < 8; ++i) { const int kk = 8 * i + rr; v[i] = (n0 + c4 < N) ? *(const f32x4*)(W + (size_t)(k0 + kk) * N + n0 + c4) : (f32x4){0.f, 0.f, 0.f, 0.f}; }
#pragma unroll
    for (int i = 0; i < 8; ++i) { const int kk = 8 * i + rr; const float sc = kscale ? kscale[k0 + kk] : 1.f; LAS float* d = scr + kk * 33 + c4;
        d[0] = v[i][0] * sc; d[1] = v[i][1] * sc; d[2] = v[i][2] * sc; d[3] = v[i][3] * sc; }
    asm volatile("s_waitcnt lgkmcnt(0)" ::: "memory");
    int d0 = n0;
    if (upmap) d0 = (n0 < DFF) ? (n0 / 128) * 256 + (n0 % 128) : ((n0 - DFF) / 128) * 256 + 128 + ((n0 - DFF) % 128);
    const int c = lane & 7;
#pragma unroll
    for (int j = 0; j < 4; ++j) { const int n = (lane >> 3) + 8 * j; const LAS float* sp = scr + (8 * c) * 33 + n;
        u32x4 o; o.x = cvt_pk_bf16(sp[0 * 33], sp[1 * 33]); o.y = cvt_pk_bf16(sp[2 * 33], sp[3 * 33]); o.z = cvt_pk_bf16(sp[4 * 33], sp[5 * 33]); o.w = cvt_pk_bf16(sp[6 * 33], sp[7 * 33]);
        *(u32x4*)(WT + (size_t)(d0 + n) * K + k0 + 8 * c) = o; }
    asm volatile("s_waitcnt lgkmcnt(0)" ::: "memory");
}

__device__ __forceinline__ void s5_build(CArgs* args, Frame& F, int l, int g, int q) {
    LAS float* apr = (LAS float*)(F.lds);
    LAS float* api = apr + 33 * 65;
    LAS float* bbr = api + 33 * 65;
    LAS float* bbi = bbr + 64 * 16;
    LAS float* crr = bbi + 64 * 16;
    LAS float* cii = crr + 16 * 65;
    LAS float* km = cii + 16 * 65 + 2;
    LAS float* dd = km + 32 * 264;
    const float* lam_re = args->in[4] + ((size_t)l * 16 + g) * 64; const float* lam_im = args->in[5] + ((size_t)l * 16 + g) * 64;
    const float dt = __expf(args->in[6][l * 16 + g]);
    const float* b_re = args->in[7] + ((size_t)l * 16 + g) * 64 * 16; const float* b_im = args->in[8] + ((size_t)l * 16 + g) * 64 * 16;
    const float* c_re = args->in[9] + ((size_t)l * 16 + g) * 16 * 64; const float* c_im = args->in[10] + ((size_t)l * 16 + g) * 16 * 64;
    const float* dsk = args->in[11] + (size_t)l * 256 + g * 16;
    const int tid = F.tid;
    if (tid < 64) { const int p = tid; const float lr = fminf(lam_re[p], -1e-4f), li = lam_im[p];
        for (int j = 0; j <= 32; ++j) { const float mag = __expf((float)j * lr * dt); float sn, cs; sincos_rev((float)j * li * dt, sn, cs); apr[j * 65 + p] = mag * cs; api[j * 65 + p] = mag * sn; }
        const float mag = __expf(lr * dt); float sn, cs; sincos_rev(li * dt, sn, cs); const float are = mag * cs, aim = mag * sn, den = lr * lr + li * li;
        const float fre = ((are - 1.f) * lr + aim * li) / den, fim = (aim * lr - (are - 1.f) * li) / den;
        for (int c = 0; c < 16; ++c) { const float br = b_re[p * 16 + c], bi = b_im[p * 16 + c]; bbr[p * 16 + c] = fre * br - fim * bi; bbi[p * 16 + c] = fre * bi + fim * br; } }
    for (int i = tid; i < 1024; i += 512) { crr[(i >> 6) * 65 + (i & 63)] = c_re[i]; cii[(i >> 6) * 65 + (i & 63)] = c_im[i]; }
    if (tid < 16) dd[tid] = dsk[tid];
    __syncthreads();
    { const int j = tid >> 4, c = tid & 15; float sacc[16];
#pragma unroll
      for (int c2 = 0; c2 < 16; ++c2) sacc[c2] = 0.f;
      for (int p = 0; p < 64; ++p) { const float cr = crr[c * 65 + p], ci = cii[c * 65 + p], ar = apr[j * 65 + p], ai = api[j * 65 + p]; const float xr = cr * ar - ci * ai, xi = cr * ai + ci * ar;
#pragma unroll
          for (int c2 = 0; c2 < 16; ++c2) sacc[c2] += xr * bbr[p * 16 + c2] - xi * bbi[p * 16 + c2]; }
#pragma unroll
      for (int c2 = 0; c2 < 16; ++c2) km[j * 264 + c * 16 + c2] = sacc[c2]; }
    __syncthreads();
    bf16_t* A = (bf16_t*)(F.ws + WS_S5A) + (size_t)g * 768 * 512; bf16_t* B = (bf16_t*)(F.ws + WS_S5B) + (size_t)g * 512 * 256;
    for (int v = q * 192 * 64 + tid; v < (q + 1) * 192 * 64; v += 512) { const int row = v >> 6, col0 = (v & 63) * 8, s = col0 >> 4, c0 = col0 & 15; float o[8];
        if (row < 512) { const int t = row >> 4, c = row & 15;
#pragma unroll
            for (int e = 0; e < 8; ++e) o[e] = 0.f;
            if (s <= t) { const f32x4 k0v = *(const LAS f32x4*)(km + (t - s) * 264 + c * 16 + c0), k1v = *(const LAS f32x4*)(km + (t - s) * 264 + c * 16 + c0 + 4);
                o[0] = k0v[0]; o[1] = k0v[1]; o[2] = k0v[2]; o[3] = k0v[3]; o[4] = k1v[0]; o[5] = k1v[1]; o[6] = k1v[2]; o[7] = k1v[3];
#pragma unroll
                for (int e = 0; e < 8; ++e) if (s == t && c0 + e == c) o[e] += dd[c]; }
        } else if (row < 640) { const int q = row - 512, p = q & 63, im = q >> 6; const float ar = apr[(31 - s) * 65 + p], ai = api[(31 - s) * 65 + p];
#pragma unroll
            for (int e = 0; e < 8; ++e) { const float br = bbr[p * 16 + c0 + e], bi = bbi[p * 16 + c0 + e]; o[e] = im ? (ar * bi + ai * br) : (ar * br - ai * bi); }
        } else { *(u32x4*)(A + (size_t)row * 512 + col0) = (u32x4){0u, 0u, 0u, 0u}; continue; }
        u32x4 w; w.x = cvt_pk_bf16(o[0], o[1]); w.y = cvt_pk_bf16(o[2], o[3]); w.z = cvt_pk_bf16(o[4], o[5]); w.w = cvt_pk_bf16(o[6], o[7]);
        *(u32x4*)(A + (size_t)row * 512 + col0) = w; }
    for (int v = q * 128 * 32 + tid; v < (q + 1) * 128 * 32; v += 512) { const int row = v >> 5, k0 = (v & 31) * 8, t = row >> 4, c = row & 15; float o[8];
#pragma unroll
        for (int e = 0; e < 8; ++e) { const int k = k0 + e; float x = 0.f;
            if (k < 64) x = crr[c * 65 + k] * apr[(t + 1) * 65 + k] - cii[c * 65 + k] * api[(t + 1) * 65 + k];
            else if (k < 128) { const int p = k - 64; x = -(crr[c * 65 + p] * api[(t + 1) * 65 + p] + cii[c * 65 + p] * apr[(t + 1) * 65 + p]); }
            o[e] = x; }
        u32x4 w; w.x = cvt_pk_bf16(o[0], o[1]); w.y = cvt_pk_bf16(o[2], o[3]); w.z = cvt_pk_bf16(o[4], o[5]); w.w = cvt_pk_bf16(o[6], o[7]);
        *(u32x4*)(B + (size_t)row * 256 + k0) = w; }
    __syncthreads();
}

__device__ __forceinline__ void attn_prep(CArgs* args, Frame& F) {
    LAS float* scr = (LAS float*)(F.lds + F.wave * 8448);
    const int gw = F.wg * 8 + F.wave, NGW = F.G * 8;
    for (int it = gw; it < 4 * 3 * 512; it += NGW) { const int l = it / 1536, r = it % 1536, wsel = r / 512, item = r % 512;
        unsigned char* tb = F.ws + WS_TMP + (size_t)l * TMP_L;
        const float* src = args->in[wsel == 0 ? 23 : (wsel == 1 ? 24 : 25)] + (size_t)l * D * D;
        tr_item(src, D, D, (bf16_t*)(tb + (wsel == 0 ? 2 : (wsel == 1 ? 4 : 6)) * MiB), nullptr, 0, scr, item, 32, F.lane); }
    for (int v = F.wg * 512 + F.tid; v < 4 * D * D / 8; v += F.G * 512) { const int l = v >> 17, vv = v & 131071, d = vv >> 7; const float* wq = args->in[22] + (size_t)l * D * D;
        const float sc = args->in[20][l * D + d] * 0.0625f; const f32x4 a = *(const f32x4*)(wq + (size_t)vv * 8) * sc, b = *(const f32x4*)(wq + (size_t)vv * 8 + 4) * sc;
        *(u32x4*)((bf16_t*)(F.ws + WS_TMP + (size_t)l * TMP_L) + (size_t)vv * 8) = pack8(a, b); }
    for (int mm = gw; mm < 4 * 512; mm += NGW) { const int l = mm >> 9, m = mm & 511; const float* mr = args->in[1] + (size_t)m * D; const float* memw = args->in[21] + l * D; f32x4 v[4]; float s = 0.f;
#pragma unroll
        for (int j = 0; j < 4; ++j) { v[j] = *(const f32x4*)(mr + 4 * F.lane + 256 * j); s += (v[j][0] * v[j][0] + v[j][1] * v[j][1]) + (v[j][2] * v[j][2] + v[j][3] * v[j][3]); }
        const float rs = rsqrtf(wave_sum(s) * (1.f / D) + EPS); bf16_t* o = (bf16_t*)(F.ws + WS_TMP + (size_t)l * TMP_L + 8 * MiB) + (size_t)m * D;
#pragma unroll
        for (int j = 0; j < 4; ++j) { const f32x4 w = *(const f32x4*)(memw + 4 * F.lane + 256 * j); u32x2 p; p.x = cvt_pk_bf16(v[j][0] * rs * w[0], v[j][1] * rs * w[1]); p.y = cvt_pk_bf16(v[j][2] * rs * w[2], v[j][3] * rs * w[3]);
            *(u32x2*)(o + 4 * F.lane + 256 * j) = p; } }
    {
        float* ssq = (float*)(F.ws + WS_SSQ); bf16_t* xb = (bf16_t*)(F.ws + WS_XB);
        for (int m = gw; m < T; m += NGW) { const float* xr = args->in[0] + (size_t)m * D; f32x4 v[4]; float s = 0.f;
#pragma unroll
            for (int j = 0; j < 4; ++j) { v[j] = *(const f32x4*)(xr + 4 * F.lane + 256 * j); s += (v[j][0] * v[j][0] + v[j][1] * v[j][1]) + (v[j][2] * v[j][2] + v[j][3] * v[j][3]); }
            s = wave_sum(s);
#pragma unroll
            for (int j = 0; j < 4; ++j) { u32x2 p; p.x = cvt_pk_bf16(v[j][0], v[j][1]); p.y = cvt_pk_bf16(v[j][2], v[j][3]); *(u32x2*)(xb + (size_t)m * D + 4 * F.lane + 256 * j) = p; }
            if (F.lane < 16) ssq[(size_t)m * 16 + F.lane] = (F.lane == 0) ? s : 0.f; } }
}
__device__ __forceinline__ void prep_phase(CArgs* args, Frame& F, int l, int what) {
    if (!(what & 1)) return;
    if (F.wg >= F.G - 64) { s5_build(args, F, l, (F.wg - (F.G - 64)) >> 2, (F.wg - (F.G - 64)) & 3); return; }
    LAS float* scr = (LAS float*)(F.lds + F.wave * 8448);
    const int gw = F.wg * 8 + F.wave, NGW = (F.G - 64) * 8;
    const float* w_in = args->in[3] + (size_t)l * D * INC; const float* w_out = args->in[19] + (size_t)l * D * D;
    const float* w_up = args->in[27] + (size_t)l * D * 2 * DFF; const float* w_down = args->in[30] + (size_t)l * DFF * D; const float* w_glu = args->in[12] + (size_t)l * 256 * 256;
    const float* mixw = args->in[2] + l * D; const float* ffw = args->in[26] + l * D; const float* ssdnw = args->in[18] + l * 768;
    constexpr int I_IN = 16 * 96, I_OUT = 16 * 32, I_UP = 16 * 176, I_DN = 44 * 32, I_GLU = 4 * 8;
    constexpr int NITEMS = I_IN + I_OUT + I_UP + I_DN + I_GLU;
    for (int it = gw; it < NITEMS; it += NGW) {
        int r = it;
        if (r < I_IN) { tr_item(w_in, D, INC, (bf16_t*)(F.ws + WS_WIN), mixw, 0, scr, r, 96, F.lane); continue; } r -= I_IN;
        if (r < I_OUT) { const int kb = r / 32, k0 = 64 * kb; tr_item(w_out, D, D, (bf16_t*)(F.ws + WS_WOUT), k0 >= 256 ? ssdnw - 256 : nullptr, 0, scr, r, 32, F.lane); continue; } r -= I_OUT;
        if (r < I_UP) { tr_item(w_up, D, 2 * DFF, (bf16_t*)(F.ws + WS_WUP), ffw, 1, scr, r, 176, F.lane); continue; } r -= I_UP;
        if (r < I_DN) { tr_item(w_down, DFF, D, (bf16_t*)(F.ws + WS_WDOWN), nullptr, 0, scr, r, 32, F.lane); continue; } r -= I_DN;
        tr_item(w_glu, 256, 256, (bf16_t*)(F.ws + WS_WGLU), nullptr, 0, scr, r, 8, F.lane);
    }
}

constexpr int SP = 272;
__device__ __forceinline__ void ssd_tables(CArgs* args, Frame& F, int l, int chunk, LAS float* dtv, LAS float* acs) {
    const float* DT = (const float*)(F.ws + WS_DT) + (size_t)chunk * 128 * 16;
    for (int h = F.wave; h < 12; h += 8) { const float bias = args->in[15][l * 12 + h], a = -__expf(args->in[16][l * 12 + h]);
        float x0 = DT[(size_t)F.lane * 16 + h] + bias, x1 = DT[(size_t)(F.lane + 64) * 16 + h] + bias;
        const float d0 = softplus_f(x0), d1 = softplus_f(x1);
        float s0 = d0 * a, s1 = d1 * a;
#pragma unroll
        for (int o = 1; o < 64; o <<= 1) { const float t0 = __shfl_up(s0, o), t1 = __shfl_up(s1, o); if (F.lane >= o) { s0 += t0; s1 += t1; } }
        s1 += __shfl(s0, 63);
        dtv[h * 128 + F.lane] = d0; dtv[h * 128 + F.lane + 64] = d1; acs[h * 128 + F.lane] = s0; acs[h * 128 + F.lane + 64] = s1; }
}
__device__ __forceinline__ void ssd_conv_load(Frame& F, int chunk, int l0, int xcol, u32x4 (&xr)[11]) {
    const bf16_t* proj = (const bf16_t*)(F.ws + WS_PROJ);
    const bool bstart = (chunk & 127) == 0;
#pragma unroll
    for (int r = 0; r < 11; ++r) { const int lr = l0 + r - 3; const bool ok = (lr >= 0) || !bstart;
        xr[r] = ok ? *(const u32x4*)(proj + (size_t)(chunk * 128 + lr) * PLD + 1024 + xcol) : (u32x4){0u, 0u, 0u, 0u}; }
}
template <bool TR>
__device__ __forceinline__ void ssd_conv_math(CArgs* args, int l, int l0, int xcol, const LAS float* sc, const u32x4 (&xr)[11], u32x4 (&o)[8]) {
    const float* cw = args->in[13] + (size_t)l * 4 * 1792 + xcol; const float* cbp = args->in[14] + (size_t)l * 1792 + xcol;
    float scv[8];
#pragma unroll
    for (int i = 0; i < 8; ++i) scv[i] = (TR && sc) ? sc[l0 + i] : 1.f;
    const f32x4 W0[2] = {*(const f32x4*)cw, *(const f32x4*)(cw + 4)}, W1[2] = {*(const f32x4*)(cw + 1792), *(const f32x4*)(cw + 1796)}, W2[2] = {*(const f32x4*)(cw + 3584), *(const f32x4*)(cw + 3588)},
                W3[2] = {*(const f32x4*)(cw + 5376), *(const f32x4*)(cw + 5380)}, BV[2] = {*(const f32x4*)cbp, *(const f32x4*)(cbp + 4)};
#pragma unroll
    for (int jp = 0; jp < 4; ++jp) { float ya[8], yb[8];
#pragma unroll
        for (int hh = 0; hh < 2; ++hh) { const int j = 2 * jp + hh; const float w0 = W0[j >> 2][j & 3], w1 = W1[j >> 2][j & 3], w2 = W2[j >> 2][j & 3], w3 = W3[j >> 2][j & 3], bsv = BV[j >> 2][j & 3]; float x[11];
#pragma unroll
            for (int r = 0; r < 11; ++r) { const unsigned wd = xr[r][jp]; x[r] = hh ? bfhi(wd) : bflo(wd); }
#pragma unroll
            for (int i = 0; i < 8; ++i) { const float y = silu_f(__builtin_fmaf(w3, x[i + 3], __builtin_fmaf(w2, x[i + 2], __builtin_fmaf(w1, x[i + 1], __builtin_fmaf(w0, x[i], bsv))))) * scv[i]; if (hh) yb[i] = y; else ya[i] = y; } }
        if (TR) { o[2 * jp].x = cvt_pk_bf16(ya[0], ya[1]); o[2 * jp].y = cvt_pk_bf16(ya[2], ya[3]); o[2 * jp].z = cvt_pk_bf16(ya[4], ya[5]); o[2 * jp].w = cvt_pk_bf16(ya[6], ya[7]);
                  o[2 * jp + 1].x = cvt_pk_bf16(yb[0], yb[1]); o[2 * jp + 1].y = cvt_pk_bf16(yb[2], yb[3]); o[2 * jp + 1].z = cvt_pk_bf16(yb[4], yb[5]); o[2 * jp + 1].w = cvt_pk_bf16(yb[6], yb[7]); }
        else {
#pragma unroll
            for (int i = 0; i < 8; ++i) o[i][jp] = cvt_pk_bf16(ya[i], yb[i]); } }
}
__device__ __forceinline__ void ssd_s1(CArgs* args, Frame& F, int l) {
    LAS unsigned char* XT = F.lds;
    LAS unsigned char* BT = F.lds + 192 * SP;
    LAS float* dtv = (LAS float*)(F.lds + 320 * SP);
    LAS float* acs = dtv + 12 * 128;
    LAS float* scl = acs + 12 * 128;
    const int fr = F.lane & 15, fq = F.lane >> 4, w = F.wave;
    bf16_t* ST = (bf16_t*)(F.ws + WS_ST); float* CDp = (float*)(F.ws + WS_CD); bf16_t* xp = (bf16_t*)F.out;
    for (int chunk = F.wg; chunk < 256; chunk += F.G) {
        __syncthreads();
        ssd_tables(args, F, l, chunk, dtv, acs);
        __syncthreads();
        for (int i = F.tid; i < 12 * 128; i += 512) { const int h = i >> 7; scl[i] = dtv[i] * __expf(acs[h * 128 + 127] - acs[i]); }
        if (F.tid < 12) CDp[chunk * 16 + F.tid] = __expf(acs[F.tid * 128 + 127]);
        __syncthreads();
        for (int g = 0; g < 4; ++g) {
            for (int id = F.tid; id < 40 * 16; id += 512) { const int rb = id & 15, cbk = id >> 4, l0 = rb * 8; u32x4 o[8], xa[11];
                const int xcol = (cbk < 24) ? 192 * g + cbk * 8 : 768 + 128 * g + (cbk - 24) * 8;
                ssd_conv_load(F, chunk, l0, xcol, xa);
                if (cbk < 24) { const int hp0 = cbk * 8; const int h = 3 * g + (hp0 >> 6); ssd_conv_math<true>(args, l, l0, xcol, scl + h * 128, xa, o);
#pragma unroll
                    for (int j = 0; j < 8; ++j) *(LAS u32x4*)(XT + (hp0 + j) * SP + l0 * 2) = o[j];
                } else { const int n0 = (cbk - 24) * 8; ssd_conv_math<true>(args, l, l0, xcol, nullptr, xa, o);
#pragma unroll
                    for (int j = 0; j < 8; ++j) *(LAS u32x4*)(BT + (n0 + j) * SP + l0 * 2) = o[j]; } }
            __syncthreads();
            f32x4 acc[12];
#pragma unroll
            for (int mi = 0; mi < 12; ++mi) acc[mi] = (f32x4){0.f, 0.f, 0.f, 0.f};
#pragma unroll
            for (int kb = 0; kb < 4; ++kb) { const bf16x8 bf = *(const LAS bf16x8*)(BT + (16 * w + fr) * SP + (32 * kb + 8 * fq) * 2);
#pragma unroll
                for (int mi = 0; mi < 12; ++mi) { const bf16x8 af = *(const LAS bf16x8*)(XT + (16 * mi + fr) * SP + (32 * kb + 8 * fq) * 2);
                    acc[mi] = __builtin_amdgcn_mfma_f32_16x16x32_bf16(bf, af, acc[mi], 0, 0, 0); } }
#pragma unroll
            for (int mi = 0; mi < 12; ++mi) { const int hp = 16 * mi + fr, h = 3 * g + (hp >> 6), p = hp & 63; u32x2 o; o.x = cvt_pk_bf16(acc[mi][0], acc[mi][1]); o.y = cvt_pk_bf16(acc[mi][2], acc[mi][3]);
                *(u32x2*)(ST + (((size_t)chunk * 12 + h) * 64 + p) * 128 + 16 * w + 4 * fq) = o; }
            __syncthreads();
        }
    }
}
__device__ __forceinline__ void ssd_s2(Frame& F, int nwg) {
    u32x2* ST = (u32x2*)(F.ws + WS_ST); const float* CDp = (const float*)(F.ws + WS_CD);
    const int PER = 12 * 64 * 32, NTH = 2 * PER;
    for (int id = F.wg * 512 + F.tid; id < NTH; id += nwg * 512) { const int b = id / PER, r = id % PER, h = r / 2048;
        float c0 = 0.f, c1 = 0.f, c2 = 0.f, c3 = 0.f;
        for (int c8 = 0; c8 < 128; c8 += 16) { u32x2 v[16]; float dec[16];
#pragma unroll
            for (int i = 0; i < 16; ++i) { const int ch = b * 128 + c8 + i; v[i] = ST[(size_t)ch * PER + r]; dec[i] = CDp[ch * 16 + h]; }
#pragma unroll
            for (int i = 0; i < 16; ++i) { const int ch = b * 128 + c8 + i; u32x2 o; o.x = cvt_pk_bf16(c0, c1); o.y = cvt_pk_bf16(c2, c3); ST[(size_t)ch * PER + r] = o;
                c0 = c0 * dec[i] + bflo(v[i].x); c1 = c1 * dec[i] + bfhi(v[i].x); c2 = c2 * dec[i] + bflo(v[i].y); c3 = c3 * dec[i] + bfhi(v[i].y); } } }
}
__device__ __forceinline__ void ssd_s3(CArgs* args, Frame& F, int l) {
    LAS unsigned char* Cs = F.lds;
    LAS unsigned char* Bs = F.lds + 128 * SP;
    LAS unsigned char* XT = F.lds + 256 * SP;
    LAS float* dtv = (LAS float*)(F.lds + 448 * SP);
    LAS float* acs = dtv + 12 * 128;
    const int fr = F.lane & 15, fq = F.lane >> 4, w = F.wave;
    const bf16_t* ST = (const bf16_t*)(F.ws + WS_ST); const bf16_t* proj = (const bf16_t*)(F.ws + WS_PROJ); bf16_t* ycat = (bf16_t*)(F.ws + WS_YCAT); const bf16_t* xp = (const bf16_t*)F.out;
    for (int chunk = F.wg; chunk < 256; chunk += F.G) {
        __syncthreads();
        ssd_tables(args, F, l, chunk, dtv, acs);
        const int lrow = 16 * w + fr; const size_t tok = (size_t)chunk * 128 + lrow;
        float ssq = 0.f;
        bf16x8 pf[16]; u32x2 zq[4];
#define LOAD_HEAD(hh_) do { const bf16_t* prev_ = ST + ((size_t)chunk * 12 + (hh_)) * 64 * 128; \
            _Pragma("unroll") for (int kb_ = 0; kb_ < 4; ++kb_) _Pragma("unroll") for (int ni_ = 0; ni_ < 4; ++ni_) pf[kb_ * 4 + ni_] = *(const bf16x8*)(prev_ + (size_t)(16 * ni_ + fr) * 128 + 32 * kb_ + 8 * fq); \
            _Pragma("unroll") for (int ni_ = 0; ni_ < 4; ++ni_) zq[ni_] = *(const u32x2*)(proj + tok * PLD + 256 + 64 * (hh_) + 16 * ni_ + 4 * fq); } while (0)
        for (int g = 0; g < 4; ++g) {
            __syncthreads();
            for (int id = F.tid; id < 56 * 16; id += 512) { const int rb = (id < 384) ? (id & 15) : ((id - 384) >> 5), cbk = (id < 384) ? (id >> 4) : 24 + ((id - 384) & 31), l0 = rb * 8; u32x4 o[8], xa[11];
                const int xcol = (cbk < 24) ? 192 * g + cbk * 8 : (cbk < 40 ? 768 + 128 * g + (cbk - 24) * 8 : 1280 + 128 * g + (cbk - 40) * 8);
                ssd_conv_load(F, chunk, l0, xcol, xa);
                if (cbk < 24) { const int hp0 = cbk * 8; ssd_conv_math<true>(args, l, l0, xcol, nullptr, xa, o);
#pragma unroll
                    for (int j = 0; j < 8; ++j) *(LAS u32x4*)(XT + (hp0 + j) * SP + l0 * 2) = o[j];
                } else { const bool isB = cbk < 40; const int n0 = (isB ? cbk - 24 : cbk - 40) * 8; ssd_conv_math<false>(args, l, l0, xcol, nullptr, xa, o);
                    LAS unsigned char* dst = isB ? Bs : Cs;
#pragma unroll
                    for (int i = 0; i < 8; ++i) *(LAS u32x4*)(dst + (l0 + i) * SP + n0 * 2) = o[i]; } }
            __syncthreads();
            LOAD_HEAD(3 * g);
            f32x4 cbv[8];
#pragma unroll
            for (int ni = 0; ni < 8; ++ni) cbv[ni] = (f32x4){0.f, 0.f, 0.f, 0.f};
#pragma unroll
            for (int kb = 0; kb < 4; ++kb) { const bf16x8 af = *(const LAS bf16x8*)(Cs + lrow * SP + (32 * kb + 8 * fq) * 2);
#pragma unroll
                for (int ni = 0; ni < 8; ++ni) { const bf16x8 bf = *(const LAS bf16x8*)(Bs + (16 * ni + fr) * SP + (32 * kb + 8 * fq) * 2);
                    cbv[ni] = __builtin_amdgcn_mfma_f32_16x16x32_bf16(bf, af, cbv[ni], 0, 0, 0); } }
            __syncthreads();
            for (int hl = 0; hl < 3; ++hl) { const int h = 3 * g + hl; const float al = acs[h * 128 + lrow];
#pragma unroll
                for (int ni = 0; ni < 8; ++ni) { const int s0 = 16 * ni + 4 * fq; const f32x4 as = *(const LAS f32x4*)(acs + h * 128 + s0), ds = *(const LAS f32x4*)(dtv + h * 128 + s0); float o[4];
#pragma unroll
                    for (int j = 0; j < 4; ++j) o[j] = (s0 + j <= lrow) ? cbv[ni][j] * __expf(al - as[j]) * ds[j] : 0.f;
                    u32x2 pkd; pkd.x = cvt_pk_bf16(o[0], o[1]); pkd.y = cvt_pk_bf16(o[2], o[3]); *(LAS u32x2*)(Bs + lrow * SP + s0 * 2) = pkd; }
                asm volatile("s_waitcnt lgkmcnt(0)" ::: "memory");
                f32x4 acc[4];
#pragma unroll
                for (int ni = 0; ni < 4; ++ni) acc[ni] = (f32x4){0.f, 0.f, 0.f, 0.f};
#pragma unroll
                for (int kb = 0; kb < 4; ++kb) { const bf16x8 af = *(const LAS bf16x8*)(Cs + lrow * SP + (32 * kb + 8 * fq) * 2);
#pragma unroll
                    for (int ni = 0; ni < 4; ++ni) acc[ni] = __builtin_amdgcn_mfma_f32_16x16x32_bf16(pf[kb * 4 + ni], af, acc[ni], 0, 0, 0); }
                const float eal = __expf(al);
#pragma unroll
                for (int ni = 0; ni < 4; ++ni) acc[ni] *= eal;
#pragma unroll
                for (int kb = 0; kb < 4; ++kb) { const bf16x8 af = *(const LAS bf16x8*)(Bs + lrow * SP + (32 * kb + 8 * fq) * 2);
#pragma unroll
                    for (int ni = 0; ni < 4; ++ni) { const bf16x8 bf = *(const LAS bf16x8*)(XT + (64 * hl + 16 * ni + fr) * SP + (32 * kb + 8 * fq) * 2);
                        acc[ni] = __builtin_amdgcn_mfma_f32_16x16x32_bf16(bf, af, acc[ni], 0, 0, 0); } }
                const float dsk = args->in[17][l * 12 + h];
                u32x2 zc[4];
#pragma unroll
                for (int ni = 0; ni < 4; ++ni) zc[ni] = zq[ni];
                if (hl < 2) LOAD_HEAD(h + 1);
#pragma unroll
                for (int ni = 0; ni < 4; ++ni) { const int p0 = 16 * ni + 4 * fq; const u32x2 zz = zc[ni]; float o[4];
#pragma unroll
                    for (int j = 0; j < 4; ++j) { const float xv = bf1(*(const LAS bf16_t*)(XT + (64 * hl + p0 + j) * SP + lrow * 2)); const unsigned zw = (j < 2) ? zz.x : zz.y; const float z = (j & 1) ? bfhi(zw) : bflo(zw);
                        o[j] = (acc[ni][j] + xv * dsk) * silu_f(z); ssq += o[j] * o[j]; }
                    u32x2 pkd; pkd.x = cvt_pk_bf16(o[0], o[1]); pkd.y = cvt_pk_bf16(o[2], o[3]); *(u32x2*)(ycat + tok * D + 256 + 64 * h + p0) = pkd; }
                asm volatile("s_waitcnt lgkmcnt(0)" ::: "memory");
            }
        }
        ssq += __shfl_xor(ssq, 16); ssq += __shfl_xor(ssq, 32);
        { const float ms = ssq * (1.f / 768.f) + EPS; if (fq == 0) *(f32x2*)((float*)(F.ws + WS_RSD) + tok * 2) = (f32x2){rsqrtf(ms), sqrtf(ms)}; }
    }
}
__device__ __forceinline__ void s5_scan(CArgs* args, Frame& F, int l, int wgl, int nwg) {
    const float* hloc = (const float*)(F.ws + WS_HLOC); bf16_t* hprev = (bf16_t*)(F.ws + WS_HPREV);
    LAS float* E = (LAS float*)F.lds;
    for (int bg = wgl; bg < 32; bg += nwg) { const int b = bg >> 4, g = bg & 15, p = F.lane, w = F.wave;
        const float lr = fminf(args->in[4][((size_t)l * 16 + g) * 64 + p], -1e-4f), li = args->in[5][((size_t)l * 16 + g) * 64 + p], dt = __expf(args->in[6][l * 16 + g]);
        const float mag = __expf(32.f * lr * dt); float sn, cs; sincos_rev(32.f * li * dt, sn, cs); const float ar = mag * cs, ai = mag * sn;
        const size_t c0 = (size_t)b * 512 + 64 * w;
        float hr = 0.f, hi = 0.f;
        for (int k8 = 0; k8 < 64; k8 += 16) { float xr[16], xi[16];
#pragma unroll
            for (int i = 0; i < 16; ++i) { const size_t o = ((c0 + k8 + i) * 16 + g) * 128; xr[i] = hloc[o + p]; xi[i] = hloc[o + 64 + p]; }
#pragma unroll
            for (int i = 0; i < 16; ++i) { const float nr = ar * hr - ai * hi + xr[i], ni = ar * hi + ai * hr + xi[i]; hr = nr; hi = ni; } }
        __syncthreads();
        E[(w * 2) * 64 + p] = hr; E[(w * 2 + 1) * 64 + p] = hi;
        __syncthreads();
        float Ar = ar, Ai = ai;
#pragma unroll
        for (int i = 0; i < 6; ++i) { const float t = Ar * Ar - Ai * Ai; Ai = 2.f * Ar * Ai; Ar = t; }
        hr = 0.f; hi = 0.f;
        for (int v = 0; v < w; ++v) { const float er = E[(v * 2) * 64 + p], ei = E[(v * 2 + 1) * 64 + p]; const float nr = Ar * hr - Ai * hi + er, ni = Ar * hi + Ai * hr + ei; hr = nr; hi = ni; }
        for (int k8 = 0; k8 < 64; k8 += 16) { float xr[16], xi[16];
#pragma unroll
            for (int i = 0; i < 16; ++i) { const size_t o = ((c0 + k8 + i) * 16 + g) * 128; xr[i] = hloc[o + p]; xi[i] = hloc[o + 64 + p]; }
#pragma unroll
            for (int i = 0; i < 16; ++i) { const size_t o = ((c0 + k8 + i) * 16 + g) * 256; hprev[o + p] = (bf16_t)(cvt_pk_bf16(hr, hr) & 0xffffu); hprev[o + 64 + p] = (bf16_t)(cvt_pk_bf16(hi, hi) & 0xffffu);
                if (p < 16) *(u32x4*)(hprev + o + 128 + 8 * p) = (u32x4){0u, 0u, 0u, 0u};
                const float nr = ar * hr - ai * hi + xr[i], ni = ar * hi + ai * hr + xi[i]; hr = nr; hi = ni; } } }
}
__device__ __forceinline__ void ffn_fixup(CArgs* args, Frame& F, int l) {
    const float* gf = (const float*)(F.ws + WS_GF); const float* vf = (const float*)(F.ws + WS_VF); const float* gl = (const float*)(F.ws + WS_GL); bf16_t* act = (bf16_t*)(F.ws + WS_ACT);
    const float* cw = args->in[28] + (size_t)l * 3 * DFF; const float* cb = args->in[29] + (size_t)l * DFF;
    for (int v = F.wg * 512 + F.tid; v < 512 * 2 * (DFF / 4); v += F.G * 512) { const int c4 = (v % (DFF / 4)) * 4, qi = v / (DFF / 4), i = qi & 1, q = qi >> 1; const bool bs = (q & 255) == 0;
        const f32x4 z = (f32x4){0.f, 0.f, 0.f, 0.f};
        const f32x4 g0 = *(const f32x4*)(gf + ((size_t)q * 2 + i) * DFF + c4);
        const f32x4 l1 = bs ? z : *(const f32x4*)(gl + ((size_t)(q - 1) * 2 + 1) * DFF + c4), l0 = bs ? z : *(const f32x4*)(gl + ((size_t)(q - 1) * 2 + 0) * DFF + c4);
        const f32x4 g1 = i ? *(const f32x4*)(gf + ((size_t)q * 2) * DFF + c4) : l1, g2 = i ? l1 : l0;
        const f32x4 vv = *(const f32x4*)(vf + ((size_t)q * 2 + i) * DFF + c4);
        const f32x4 gc = *(const f32x4*)(cb + c4) + *(const f32x4*)(cw + 2 * DFF + c4) * g0 + *(const f32x4*)(cw + DFF + c4) * g1 + *(const f32x4*)(cw + c4) * g2;
        u32x2 o; o.x = cvt_pk_bf16(silu_f(gc[0]) * vv[0], silu_f(gc[1]) * vv[1]); o.y = cvt_pk_bf16(silu_f(gc[2]) * vv[2], silu_f(gc[3]) * vv[3]);
        *(u32x2*)(act + ((size_t)q * 64 + i) * DFF + c4) = o; }
}
__device__ __forceinline__ void final_norm(CArgs* args, Frame& F) {
    const float* ssq = (const float*)(F.ws + WS_SSQ); const float* fw = args->in[31]; const bf16_t* xb = (const bf16_t*)(F.ws + WS_XB);
    const int gw = F.wg * 8 + F.wave, NGW = F.G * 8;
    for (int m = gw; m < T; m += NGW) { float s = (F.lane < 16) ? ssq[(size_t)m * 16 + F.lane] : 0.f; s = wave_sum(s); const float rs = rsqrtf(s * (1.f / D) + EPS);
        float* xr = F.out + (size_t)m * D;
#pragma unroll
        for (int j = 0; j < 4; ++j) { const u32x2 v = *(const u32x2*)(xb + (size_t)m * D + 4 * F.lane + 256 * j); const f32x4 w = *(const f32x4*)(fw + 4 * F.lane + 256 * j);
            *(f32x4*)(xr + 4 * F.lane + 256 * j) = (f32x4){bflo(v.x), bfhi(v.x), bflo(v.y), bfhi(v.y)} * rs * w; } }
}

#define XB_TMO      128
#define XB_XCNT(j)  (256  + 64 * (j))
#define XB_XSUB(j)  (1280 + 64 * (j))
#define XB_XGEN(j)  (2304 + 64 * (j))
#define XB_TOP      3328
#define XB_TOPGEN   3392
#define XCD_BAR_WORDS 3456
#define XB_SPIN_CAP (1u << 22)
__device__ __forceinline__ unsigned xb_ld(unsigned* p)              { return __hip_atomic_load(p, __ATOMIC_RELAXED, __HIP_MEMORY_SCOPE_AGENT); }
__device__ __forceinline__ unsigned xb_add(unsigned* p, unsigned v) { return __hip_atomic_fetch_add(p, v, __ATOMIC_RELAXED, __HIP_MEMORY_SCOPE_AGENT); }
__device__ __forceinline__ unsigned xb_xcc_id() { return (unsigned)__builtin_amdgcn_s_getreg((3 << 11) | 20) & 0xFu; }
#define XB_SPIN(cond, bar) do { unsigned _sp = 0; while (cond) { __builtin_amdgcn_s_sleep(1); \
    if ((++_sp & 255u) == 0u) { if (xb_ld(&(bar)[XB_TMO])) break; if (_sp > XB_SPIN_CAP) { atomicAdd(&(bar)[XB_TMO], 1u); break; } } } } while (0)
struct XcdBarrier { unsigned* bar; unsigned x; volatile LAS unsigned* st; };
__device__ __forceinline__ XcdBarrier xcd_barrier_post(unsigned* bar, volatile LAS unsigned* st) {
    XcdBarrier b; b.bar = bar; b.x = xb_xcc_id(); b.st = st;
    if (threadIdx.x == 0) (void)xb_add(&bar[XB_XCNT(b.x)], 1u);
    return b;
}
__device__ __forceinline__ void xcd_barrier_complete(unsigned* bar, unsigned x, unsigned& nloc, unsigned& nx) {
    const unsigned G = gridDim.x * gridDim.y * gridDim.z;
    unsigned sum, cnt, mine, sp = 0u;
    for (;;) {
        sum = 0u; cnt = 0u; mine = 0u;
#pragma unroll
        for (unsigned j = 0; j < 16; ++j) { const unsigned c = xb_ld(&bar[XB_XCNT(j)]); sum += c; cnt += (c > 0u) ? 1u : 0u; mine = (j == x) ? c : mine; }
        if (sum == G) break;
        __builtin_amdgcn_s_sleep(1);
        if ((++sp & 255u) == 0u) { if (xb_ld(&bar[XB_TMO])) break; if (sp > XB_SPIN_CAP) { atomicAdd(&bar[XB_TMO], 1u); break; } }
    }
    nloc = mine > 0u ? mine : 1u; nx = cnt > 0u ? cnt : 1u;
}
__device__ __forceinline__ void xcd_barrier(const XcdBarrier& b) {
    asm volatile("s_waitcnt vmcnt(0)" ::: "memory");
    __syncthreads();
    if (threadIdx.x == 0) {
        unsigned* bar = b.bar;
        __builtin_amdgcn_s_waitcnt(0);
        unsigned nloc = b.st[0], nx = b.st[1];
        if (nloc == 0u) { xcd_barrier_complete(bar, b.x, nloc, nx); b.st[0] = nloc; b.st[1] = nx; }
        const unsigned old = xb_add(&bar[XB_XSUB(b.x)], 1u);
        const unsigned gen = old / nloc;
        if (old + 1u == (gen + 1u) * nloc) {
            __builtin_amdgcn_fence(__ATOMIC_RELEASE, "agent");
            asm volatile("s_waitcnt vmcnt(0)" ::: "memory");
            const unsigned og = xb_add(&bar[XB_TOP], 1u);
            const unsigned tg = og / nx;
            if (og + 1u == (tg + 1u) * nx) xb_add(&bar[XB_TOPGEN], 1u);
            else XB_SPIN(xb_ld(&bar[XB_TOPGEN]) == tg, bar);
            __builtin_amdgcn_fence(__ATOMIC_ACQUIRE, "agent");
            xb_add(&bar[XB_XGEN(b.x)], 1u);
            asm volatile("s_waitcnt vmcnt(0)" ::: "memory");
        } else {
            XB_SPIN(xb_ld(&bar[XB_XGEN(b.x)]) == gen, bar);
            __builtin_amdgcn_fence(__ATOMIC_ACQUIRE, "agent");
            asm volatile("s_waitcnt vmcnt(0)" ::: "memory");
        }
    }
    __syncthreads();
}

__global__ void __launch_bounds__(512, 2) fwd_megakernel(Args args_) {
    extern __shared__ __attribute__((aligned(16))) unsigned char lds_raw[];
    cg::grid_group grid = cg::this_grid();
    Frame F; unsigned char* ws; float* ssq; bf16_t* xb; CArgs* args;
    const int wave0 = __builtin_amdgcn_readfirstlane((int)threadIdx.x >> 6);
#define PHASE_BEGIN() do { int _t; asm volatile("v_mbcnt_lo_u32_b32 %0, -1, 0\n\tv_mbcnt_hi_u32_b32 %0, -1, %0" : "=v"(_t)); _t += wave0 * 64; int _b = blockIdx.x; asm volatile("" : "+s"(_b)); args = (CArgs*)__builtin_amdgcn_kernarg_segment_ptr(); asm volatile("" : "+s"(args)); unsigned char* _w = args->ws; \
        F.lds = (LAS unsigned char*)lds_raw; F.tid = _t; F.lane = _t & 63; F.wave = __builtin_amdgcn_readfirstlane(_t >> 6); F.G = gridDim.x; F.wg = _b; F.ws = _w; F.out = args->out; \
        ws = _w; ssq = (float*)(ws + WS_SSQ); xb = (bf16_t*)(ws + WS_XB); } while (0)
    PHASE_BEGIN();
    { volatile LAS unsigned* misc = (volatile LAS unsigned*)(F.lds + MISC_OFF); if (F.tid < 64) misc[F.tid] = 0u; }
    __syncthreads();
    (void)xcd_barrier_post((unsigned*)args->ws, (volatile LAS unsigned*)(F.lds + MISC_OFF));
    grid.sync();
#ifndef PHM
#define PHM 0xFFFF
#endif

#define SYNC() do { { XcdBarrier xb_; xb_.bar = (unsigned*)args->ws; xb_.x = xb_xcc_id(); xb_.st = (volatile LAS unsigned*)(F.lds + MISC_OFF); xcd_barrier(xb_); } PHASE_BEGIN(); } while (0)
#define MKS(TYPE) TYPE S; S.G = F.G; S.c = F.wg; S.bstride = 0; S.O = nullptr; S.A2 = nullptr; S.B2 = nullptr; S.O2 = nullptr
    attn_prep(args, F);
    __syncthreads();
    prep_phase(args, F, 0, 3);
    SYNC();
    { typedef GS<3, 1024, 1024, 16, 0, 0, 64> ST_; MKS(ST_); S.A = (const char*)ws; EpiStore E{1024}; gemm_phase(F.lds, F.tid, S, E); }
    SYNC();
    { typedef GS<4, 1024, 1024, 4, 0, 0, 256> ST_; MKS(ST_); S.A = (const char*)ws; EpiStore E{1024}; gemm_phase(F.lds, F.tid, S, E); }
    SYNC();
    for (int l = 0; l < NL; ++l) {
#if PHM & (1 << 0)
        for (int rep_ = 0; rep_ <= ((args->dupm >> 0) & 1); ++rep_) {
        if (l > 0 || rep_ > 0) prep_phase(args, F, l, rep_ == 0 ? 3 : ((args->dupm >> 14) & 3));
        if (rep_ < ((args->dupm >> 0) & 1)) SYNC(); }
#endif
        if (l > 0) SYNC();
#if PHM & (1 << 3)
        for (int rep_ = 0; rep_ <= ((args->dupm >> 3) & 1); ++rep_) {
        { typedef GS<0, 1024, 1024, 16, 128, 12, 1536> ST_; MKS(ST_); S.A = (const char*)xb; S.B = (const char*)(ws + WS_WIN);
          EpiProj E{(bf16_t*)(ws + WS_PROJ), (float*)(ws + WS_DT), ssq}; gemm_phase(F.lds, F.tid, S, E); }
        if (rep_ < ((args->dupm >> 3) & 1)) SYNC(); }
#endif
        SYNC();
#if PHM & (1 << 4)
        for (int rep_ = 0; rep_ <= ((args->dupm >> 4) & 1); ++rep_) {
        ssd_s1(args, F, l);
        __syncthreads(); PHASE_BEGIN();
        { typedef GS<1, 0, 512, 8, 0, 0, 192> ST_; MKS(ST_); S.A = (const char*)(ws + WS_PROJ); S.B = (const char*)(ws + WS_S5A);
          EpiS5A E{(bf16_t*)(ws + WS_YPRE), (float*)(ws + WS_HLOC)}; gemm_phase(F.lds, F.tid, S, E); }
        if (rep_ < ((args->dupm >> 4) & 1)) SYNC(); }
#endif
        SYNC();
#if PHM & (1 << 5)
        for (int rep_ = 0; rep_ <= ((args->dupm >> 5) & 1); ++rep_) {
        if (F.wg < F.G - 32) ssd_s2(F, F.G - 32); else s5_scan(args, F, l, F.wg - (F.G - 32), 32);
        if (rep_ < ((args->dupm >> 5) & 1)) SYNC(); }
#endif
        SYNC();
#if PHM & (1 << 6)
        for (int rep_ = 0; rep_ <= ((args->dupm >> 6) & 1); ++rep_) {
        ssd_s3(args, F, l);
        __syncthreads(); PHASE_BEGIN();
        { typedef GS<2, 4096, 256, 4, 0, 0, 128> ST_; MKS(ST_); S.A = (const char*)(ws + WS_HPREV); S.B = (const char*)(ws + WS_S5B);
          EpiS5B E{(const bf16_t*)(ws + WS_YPRE), (bf16_t*)(ws + WS_YG)}; gemm_phase(F.lds, F.tid, S, E); }
        if (rep_ < ((args->dupm >> 6) & 1)) SYNC(); }
#endif
        SYNC();
#if PHM & (1 << 7)
        for (int rep_ = 0; rep_ <= ((args->dupm >> 7) & 1); ++rep_) {
        { typedef GS<0, 256, 256, 4, 128, 1, 128> ST_; MKS(ST_); S.A = (const char*)(ws + WS_YG); S.B = (const char*)(ws + WS_WGLU);
          EpiGlu E{(const bf16_t*)(ws + WS_YG), (bf16_t*)(ws + WS_YCAT), (const float*)(ws + WS_RSD)}; gemm_phase(F.lds, F.tid, S, E); }
        if (rep_ < ((args->dupm >> 7) & 1)) SYNC(); }
#endif
        SYNC();
#if PHM & (1 << 8)
        for (int rep_ = 0; rep_ <= ((args->dupm >> 8) & 1); ++rep_) {
        { typedef GS<0, 1024, 1024, 16, 128, 4, 512> ST_; MKS(ST_); S.A = (const char*)(ws + WS_YCAT); S.B = (const char*)(ws + WS_WOUT);
          EpiRes E{xb, ssq, (const float*)(ws + WS_RSD)}; gemm_phase(F.lds, F.tid, S, E); }
        if (rep_ < ((args->dupm >> 8) & 1)) SYNC(); }
#endif
        SYNC();
#if PHM & (1 << 9)
        for (int rep_ = 0; rep_ <= ((args->dupm >> 9) & 1); ++rep_) {
        { typedef GS<0, 1024, 1024, 16, 128, 4, 512> ST_; MKS(ST_); S.A = (const char*)xb; S.B = (const char*)(ws + WS_WQKA) + (size_t)l * 2 * D * D * 2; S.bstride = (size_t)D * D * 2;
          EpiSoftmax E{(bf16_t*)(ws + WS_P), ssq}; gemm_phase(F.lds, F.tid, S, E); }
        if (rep_ < ((args->dupm >> 9) & 1)) SYNC(); }
#endif
        SYNC();
#if PHM & (1 << 10)
        for (int rep_ = 0; rep_ <= ((args->dupm >> 10) & 1); ++rep_) {
        { typedef GS<0, 1024, 1024, 16, 128, 4, 512> ST_; MKS(ST_); S.A = (const char*)(ws + WS_P); S.B = (const char*)(ws + WS_WVOA) + (size_t)l * 2 * D * D * 2; S.bstride = (size_t)D * D * 2;
          EpiRes E{xb, ssq, nullptr}; gemm_phase(F.lds, F.tid, S, E); }
        if (rep_ < ((args->dupm >> 10) & 1)) SYNC(); }
#endif
        SYNC();
#if PHM & (1 << 11)
        for (int rep_ = 0; rep_ <= ((args->dupm >> 11) & 1); ++rep_) {
        { typedef GS<0, 1024, 1024, 16, 128, 22, 2816> ST_; MKS(ST_); S.A = (const char*)xb; S.B = (const char*)(ws + WS_WUP);
          EpiUp E{(bf16_t*)(ws + WS_ACT), (float*)(ws + WS_GF), (float*)(ws + WS_VF), (float*)(ws + WS_GL), ssq, args->in[28] + (size_t)l * 3 * DFF, args->in[29] + (size_t)l * DFF}; gemm_phase(F.lds, F.tid, S, E); }
        if (rep_ < ((args->dupm >> 11) & 1)) SYNC(); }
#endif
        SYNC();
#if PHM & (1 << 12)
        for (int rep_ = 0; rep_ <= ((args->dupm >> 12) & 1); ++rep_) {
        ffn_fixup(args, F, l);
        if (rep_ < ((args->dupm >> 12) & 1)) SYNC(); }
#endif
        SYNC();
#if PHM & (1 << 13)
        for (int rep_ = 0; rep_ <= ((args->dupm >> 13) & 1); ++rep_) {
        { typedef GS<0, DFF, DFF, 44, 128, 4, 512> ST_; MKS(ST_); S.A = (const char*)(ws + WS_ACT); S.B = (const char*)(ws + WS_WDOWN);
          EpiRes E{xb, ssq, nullptr}; gemm_phase(F.lds, F.tid, S, E); }
        if (rep_ < ((args->dupm >> 13) & 1)) SYNC(); }
#endif
        SYNC();
    }
    final_norm(args, F);
}

extern "C" void kernel_launch(void* const* d_in, const int* in_sizes, int n_in, void* d_out, int out_size, void* d_ws, size_t ws_size, hipStream_t stream) {
    static int grid = 0;
    if (grid == 0) {
        if (n_in != 32 || out_size != T * D || ws_size < WS_END) { fprintf(stderr, "kernel_launch: unexpected shapes (n_in %d out %d ws %zu)\n", n_in, out_size, ws_size); grid = -1; return; }
        int dev = 0, cus = 0, per_cu = 0;
        hipGetDevice(&dev); hipDeviceGetAttribute(&cus, hipDeviceAttributeMultiprocessorCount, dev);
        if (hipFuncSetAttribute((const void*)fwd_megakernel, hipFuncAttributeMaxDynamicSharedMemorySize, LDS_BYTES) != hipSuccess) { fprintf(stderr, "kernel_launch: hipFuncSetAttribute failed\n"); grid = -1; return; }
        hipOccupancyMaxActiveBlocksPerMultiprocessor(&per_cu, (const void*)fwd_megakernel, 512, LDS_BYTES);
        (void)hipGetLastError();
        if (per_cu < 1) per_cu = 1;
        grid = cus * 1;
        fprintf(stderr, "kernel_launch: cus %d per_cu %d grid %d\n", cus, per_cu, grid);
    }
    if (grid < 0) return;
    if (hipMemsetAsync(d_ws, 0, 16384, stream) != hipSuccess) { fprintf(stderr, "kernel_launch: memset failed\n"); return; }
    Args a{};
    a.dupm = PROBE_DUPM; a.sync2 = PROBE_SYNC2;
    for (int i = 0; i < 32; ++i) a.in[i] = (const float*)d_in[i];
    a.out = (float*)d_out; a.ws = (unsigned char*)d_ws;
    void* kargs[] = {&a};
    hipError_t e = hipLaunchCooperativeKernel((const void*)fwd_megakernel, dim3(grid), dim3(512), kargs, LDS_BYTES, stream);
    if (e != hipSuccess) fprintf(stderr, "cooperative launch failed: %s (grid %d)\n", hipGetErrorString(e), grid);
}
```

```cpp
#include <hip/hip_runtime.h>
#include <hip/hip_cooperative_groups.h>
#include <cstdio>
#include <cstdint>
namespace cg = cooperative_groups;

#define LAS __attribute__((address_space(3)))
typedef unsigned short bf16_t;
typedef short bf16x8 __attribute__((ext_vector_type(8)));
typedef float f32x4 __attribute__((ext_vector_type(4)));
typedef float f32x2 __attribute__((ext_vector_type(2)));
typedef unsigned u32x4 __attribute__((ext_vector_type(4)));
typedef unsigned u32x2 __attribute__((ext_vector_type(2)));

#define PROBE_DUPM 0
#define PROBE_SYNC2 0
constexpr int T = 32768, D = 1024, SEQ = 16384, NL = 4, INC = 2828, PLD = 2816, DFF = 2816;
constexpr float EPS = 1e-6f;
constexpr size_t MiB = 1u << 20;
constexpr size_t WS_WIN = 1 * MiB, WS_WOUT = 7 * MiB, WS_WQK = 9 * MiB, WS_WVO = 13 * MiB, WS_WUP = 17 * MiB, WS_WDOWN = 28 * MiB, WS_WGLU = 34 * MiB,
                 WS_S5A = 35 * MiB, WS_S5B = 47 * MiB, WS_WQS = 51 * MiB, WS_WKT = 53 * MiB, WS_WVT = 55 * MiB, WS_WOT = 57 * MiB, WS_MEMN = 59 * MiB,
                 WS_KB = 60 * MiB, WS_VB = 61 * MiB, WS_SSQ = 62 * MiB, WS_XB = 64 * MiB,
                 WS_PROJ = 128 * MiB, WS_YCAT = 304 * MiB, WS_ST = 368 * MiB, WS_YPRE = 416 * MiB, WS_YG = 432 * MiB, WS_HLOC = 448 * MiB, WS_HPREV = 456 * MiB,
                 WS_DT = 464 * MiB, WS_CD = 466 * MiB, WS_RSD = 467 * MiB, WS_WQKA = 468 * MiB, WS_WVOA = 484 * MiB, WS_END = 500 * MiB, WS_TMP = 128 * MiB, TMP_L = 11 * MiB,
                 WS_P = 128 * MiB, WS_ACT = 192 * MiB, WS_GF = 368 * MiB, WS_VF = 380 * MiB, WS_GL = 392 * MiB;
constexpr int LDS_BYTES = 147456 + 256, RING_BYTES = 131072, SPARE_OFF = 131072, MISC_OFF = 147456;

__device__ __forceinline__ unsigned cvt_pk_bf16(float lo, float hi) { unsigned r; asm volatile("v_cvt_pk_bf16_f32 %0, %1, %2" : "=v"(r) : "v"(lo), "v"(hi)); return r; }
__device__ __forceinline__ float bflo(unsigned u) { return __uint_as_float(u << 16); }
__device__ __forceinline__ float bfhi(unsigned u) { return __uint_as_float(u & 0xffff0000u); }
__device__ __forceinline__ float bf1(bf16_t b) { return __uint_as_float(((unsigned)b) << 16); }
__device__ __forceinline__ float silu_f(float x) { return x * __builtin_amdgcn_rcpf(1.f + __expf(-x)); }
__device__ __forceinline__ float sigmoid_f(float x) { return __builtin_amdgcn_rcpf(1.f + __expf(-x)); }
__device__ __forceinline__ float gelu_tanh(float x) { const float u = 0.7978845608028654f * (x + 0.044715f * x * x * x); const float t = 1.f - 2.f * __builtin_amdgcn_rcpf(1.f + __expf(2.f * u)); return 0.5f * x * (1.f + t); }
__device__ __forceinline__ void sincos_rev(float theta, float& sn, float& cs) { float r = theta * 0.15915494309189535f; r -= floorf(r); sn = __builtin_amdgcn_sinf(r); cs = __builtin_amdgcn_cosf(r); }
__device__ __forceinline__ float softplus_f(float x) { const float e = __expf(x); const float sp = (e < 0.02f) ? e * (1.f - e * (0.5f - e * 0.33333334f)) : __logf(1.f + e); return x > 20.f ? x : sp; }
__device__ __forceinline__ float wave_sum(float v) {
#pragma unroll
    for (int o = 1; o < 64; o <<= 1) v += __shfl_xor(v, o);
    return v;
}
__device__ __forceinline__ float dpp_prev1(float g0, float prev) {
    const int o = __builtin_amdgcn_update_dpp(0, __float_as_int(prev), 0x10F, 0xf, 0xf, true);
    return __int_as_float(__builtin_amdgcn_update_dpp(o, __float_as_int(g0), 0x111, 0xf, 0xf, false));
}
__device__ __forceinline__ float dpp_prev2(float g0, float prev) {
    const int o = __builtin_amdgcn_update_dpp(0, __float_as_int(prev), 0x10E, 0xf, 0xf, true);
    return __int_as_float(__builtin_amdgcn_update_dpp(o, __float_as_int(g0), 0x112, 0xf, 0xf, false));
}

#ifndef SP2
#define SP2 1
#endif
constexpr int BM = 256, BK = 64, HALF = 128, HTB = HALF * BK * 2;
__device__ __forceinline__ int lds_byte(int r, int c) { const int st = (r >> 4) * 2 + (c >> 5), rr = r & 15, cc = c & 31, ob = rr * 64 + cc * 2; return st * 1024 + (ob ^ (((ob >> 9) & 1) << 5)); }
__device__ __forceinline__ void stage_rc(int b, int& R, int& C) { const int st = b / 1024, sb = b % 1024, swz = sb ^ (((sb >> 9) & 1) << 5); R = (st >> 1) * 16 + swz / 64; C = (st & 1) * 32 + (swz % 64) / 2; }
__device__ __forceinline__ int perm32(int rho) { const int n = rho >> 4, i = rho & 15; return 8 * (i >> 2) + 4 * n + (i & 3); }

struct Unit { const char* A; const char* B; bf16_t* O; int pm, pn, z; };
template <int MODE, int LDA, int LDB, int NT, int NM, int NN, int NWG> struct GS {
    static constexpr int nt = NT, ldb = LDB;
    int G, c;
    const char* A; const char* B; size_t bstride; bf16_t* O; const char* A2; const char* B2; bf16_t* O2;
    __device__ __forceinline__ int a_off(int R, int C) const { return MODE == 1 ? (R * 32 + (C >> 4)) * PLD + (C & 15) : R * LDA + C; }
    __device__ __forceinline__ size_t a_kstep() const { return MODE == 1 ? (size_t)4 * PLD * 2 : (size_t)128; }
    __device__ __forceinline__ size_t a_hstep() const { return MODE == 1 ? (size_t)128 * 32 * PLD * 2 : (size_t)128 * LDA * 2; }
    __device__ __forceinline__ bool next(int i, Unit& u) const {
        const int L = i * G + c; if (L >= NWG) return false;
        u.O = nullptr; u.z = 0;
        if constexpr (MODE == 0) {
            int wgid = L; { constexpr int q = NWG / 8, r = NWG % 8; const int xcd = wgid % 8, off = wgid / 8; wgid = (xcd < r ? xcd * (q + 1) : r * (q + 1) + (xcd - r) * q) + off; }
            constexpr int nig = 8 * NN; const int gid = wgid / nig, fm = gid * 8, gsz = (NM - fm) < 8 ? (NM - fm) : 8;
            u.pm = fm + ((wgid % nig) % gsz); u.pn = (wgid % nig) / gsz;
            u.A = A + (size_t)u.pm * 256 * LDA * 2; u.B = B + (size_t)(u.pm >> 6) * bstride + (size_t)u.pn * 256 * LDB * 2;
        } else if constexpr (MODE == 1) {
            const int g = L / 12, r = L % 12; u.pm = r & 3; u.pn = r >> 2; u.z = g;
            u.A = A + ((size_t)u.pm * 256 * 32 * PLD + 16 * g) * 2; u.B = B + ((size_t)g * 768 + u.pn * 256) * 512 * 2;
        } else if constexpr (MODE == 2) {
            const int g = L >> 3, r = L & 7; u.pm = r & 3; u.pn = r >> 2; u.z = g;
            u.A = A + ((size_t)u.pm * 256 * 16 + g) * 256 * 2; u.B = B + ((size_t)g * 512 + u.pn * 256) * 256 * 2;
        } else if constexpr (MODE == 3) {
            const int lay = L >> 4, which = (L >> 3) & 1, pm = (L >> 2) & 1, pn = L & 3; const char* tb = A + WS_TMP + (size_t)lay * TMP_L;
            u.A = tb + 8 * MiB + (size_t)pm * 256 * 1024 * 2; u.B = tb + (which ? 4 : 2) * MiB + (size_t)pn * 256 * 1024 * 2; u.O = (bf16_t*)(tb + (which ? 10 : 9) * MiB) + (size_t)pm * 256 * 1024 + pn * 256;
            u.pm = 0; u.pn = 0;
        } else {
            const int lay = L >> 6, l6 = L & 63, l5 = l6 & 31, b = l5 >> 4, h = (l5 >> 2) & 3, p = l5 & 3; const char* tb = A + WS_TMP + (size_t)lay * TMP_L;
            if (l6 < 32) { u.A = tb + 9 * MiB + ((size_t)b * 256 * 1024 + 256 * h) * 2; u.B = tb + ((size_t)p * 256 * 1024 + 256 * h) * 2;
                           u.O = (bf16_t*)(A + WS_WQKA) + (size_t)(lay * 2 + b) * 1024 * 1024 + (size_t)(256 * h) * 1024 + 256 * p; }
            else { u.A = tb + 6 * MiB + ((size_t)p * 256 * 1024 + 256 * h) * 2; u.B = tb + 10 * MiB + ((size_t)b * 256 * 1024 + 256 * h) * 2;
                   u.O = (bf16_t*)(A + WS_WVOA) + (size_t)(lay * 2 + b) * 1024 * 1024 + (size_t)(256 * p) * 1024 + 256 * h; }
            u.pm = 0; u.pn = 0;
        }
        return true;
    }
};

typedef f32x4 AccT[2][2][4][2];

template <class Epi, class GSched>
__device__ __forceinline__ void gemm_phase(LAS unsigned char* lds, const int tid, const GSched& S, const Epi& E) {
    const int wid = __builtin_amdgcn_readfirstlane(tid >> 6), lane = tid & 63, wr = wid >> 2, wc = wid & 3, fr = lane & 15, fq = lane >> 4;
    constexpr int nt = GSched::nt;
    unsigned voffA[2], voffB[2];
#pragma unroll
    for (int i = 0; i < 2; ++i) { int R, C; stage_rc(tid * 16 + i * 8192, R, C); const int Rb = (R & ~31) + perm32(R & 31);
        voffA[i] = (unsigned)S.a_off(R, C) * 2u; voffB[i] = (unsigned)(Rb * GSched::ldb + C) * 2u; }
    const size_t kstepA = S.a_kstep(), hstepA = S.a_hstep(), kstepB = 128, hstepB = (size_t)HALF * GSched::ldb * 2;
    const unsigned ldsw = (unsigned)wid * 1024u;
    const int aoff = lds_byte(wr * 64 + fr, fq * 8), boff = lds_byte(wc * 32 + fr, fq * 8);
#define PG8_SA(b, h) (((b) * 2 + (h)) * HTB)
#define PG8_SB(b, h) ((4 + (b) * 2 + (h)) * HTB)
#define PG8_STAGE(bufoff, gbase, voff) do { _Pragma("unroll") for (int _i = 0; _i < 2; ++_i) { unsigned _vo = (voff)[_i]; asm volatile("" : "+v"(_vo)); \
        __builtin_amdgcn_global_load_lds((const unsigned*)((const char*)(gbase) + _vo), (LAS unsigned*)(lds + (bufoff) + ldsw + _i * 8192), 16, 0, 0); } } while (0)
#define PG8_LDA(dst, b, h) do { _Pragma("unroll") for (int m = 0; m < 4; ++m) _Pragma("unroll") for (int k = 0; k < 2; ++k) dst[m][k] = *(const LAS bf16x8*)(lds + PG8_SA(b, h) + aoff + m * 2048 + k * 1024); } while (0)
#define PG8_LDB(dst, b, h) do { _Pragma("unroll") for (int n = 0; n < 2; ++n) _Pragma("unroll") for (int k = 0; k < 2; ++k) dst[n][k] = *(const LAS bf16x8*)(lds + PG8_SB(b, h) + boff + n * 2048 + k * 1024); } while (0)
#define PG8_MMA(ai, bj, At, Bt) do { __builtin_amdgcn_s_setprio(1); _Pragma("unroll") for (int m = 0; m < 4; ++m) _Pragma("unroll") for (int n = 0; n < 2; ++n) _Pragma("unroll") for (int k = 0; k < 2; ++k) \
        acc[ai][bj][m][n] = __builtin_amdgcn_mfma_f32_16x16x32_bf16(Bt[n][k], At[m][k], acc[ai][bj][m][n], 0, 0, 0); __builtin_amdgcn_s_setprio(0); } while (0)
#define PG8_WAIT_V(n) asm volatile("s_waitcnt vmcnt(" #n ")" ::: "memory")
#define PG8_WAIT_L(n) asm volatile("s_waitcnt lgkmcnt(" #n ")" ::: "memory")
#define PG8_BAR __builtin_amdgcn_s_barrier()
#define PG8_SCHED __builtin_amdgcn_sched_barrier(0)
    Unit cur, nxt; int ui = 0;
    if (!S.next(0, cur)) return;
    AccT acc;
    { float zz; asm volatile("v_mov_b32 %0, 0" : "=v"(zz));
#pragma unroll
    for (int a = 0; a < 2; ++a)
#pragma unroll
        for (int b = 0; b < 2; ++b)
#pragma unroll
            for (int m = 0; m < 4; ++m)
#pragma unroll
                for (int n = 0; n < 2; ++n) acc[a][b][m][n] = (f32x4){zz, zz, zz, zz}; }
    bf16x8 At[4][2], B0[2][2], B1[2][2];
    const char* cA = cur.A; const char* cB = cur.B;
#if SP2
    PG8_STAGE(PG8_SB(0, 0), cB, voffB); PG8_STAGE(PG8_SB(0, 1), cB + hstepB, voffB); PG8_STAGE(PG8_SA(0, 0), cA, voffA); PG8_STAGE(PG8_SA(0, 1), cA + hstepA, voffA);
    if (wr == 1) PG8_BAR;
    PG8_WAIT_V(2); PG8_BAR;
    PG8_STAGE(PG8_SB(1, 0), cB + kstepB, voffB); PG8_STAGE(PG8_SA(1, 0), cA + kstepA, voffA); PG8_STAGE(PG8_SB(1, 1), cB + hstepB + kstepB, voffB);
    PG8_WAIT_V(6); PG8_BAR;
#else
    PG8_STAGE(PG8_SB(0, 0), cB, voffB); PG8_STAGE(PG8_SA(0, 0), cA, voffA); PG8_STAGE(PG8_SB(0, 1), cB + hstepB, voffB); PG8_STAGE(PG8_SA(0, 1), cA + hstepA, voffA);
    if (wr == 1) PG8_BAR;
    PG8_WAIT_V(4); PG8_BAR;
    PG8_STAGE(PG8_SB(1, 0), cB + kstepB, voffB); PG8_STAGE(PG8_SA(1, 0), cA + kstepA, voffA); PG8_STAGE(PG8_SB(1, 1), cB + hstepB + kstepB, voffB);
    PG8_WAIT_V(6); PG8_BAR;
#endif
    for (;;) {
        const bool has_next = S.next(ui + 1, nxt);
        const char* nA = has_next ? nxt.A : cA; const char* nB = has_next ? nxt.B : cB;
        for (int t = 0; t < nt; t += 2) {
            const bool last = (t == nt - 2);
            const char* a1 = cA + (size_t)(t + 1) * kstepA;
            const char* a2 = last ? nA : cA + (size_t)(t + 2) * kstepA; const char* b2 = last ? nB : cB + (size_t)(t + 2) * kstepB;
            const char* a3 = a2 + kstepA; const char* b3 = b2 + kstepB;
#if SP2
            PG8_LDB(B0, 0, 0); PG8_LDB(B1, 0, 1); PG8_SCHED; PG8_LDA(At, 0, 0); PG8_STAGE(PG8_SA(1, 1), a1 + hstepA, voffA);
            PG8_WAIT_V(8); PG8_WAIT_L(0); PG8_BAR; PG8_MMA(0, 0, At, B0); PG8_MMA(0, 1, At, B1); PG8_BAR; PG8_SCHED;
            PG8_LDA(At, 0, 1); PG8_STAGE(PG8_SB(0, 0), b2, voffB); PG8_STAGE(PG8_SB(0, 1), b2 + hstepB, voffB); PG8_STAGE(PG8_SA(0, 0), a2, voffA);
            PG8_WAIT_V(8); PG8_WAIT_L(0); PG8_BAR; PG8_MMA(1, 0, At, B0); PG8_MMA(1, 1, At, B1); PG8_BAR; PG8_SCHED;
            PG8_LDB(B0, 1, 0); PG8_LDB(B1, 1, 1); PG8_SCHED; PG8_LDA(At, 1, 0); PG8_STAGE(PG8_SA(0, 1), a2 + hstepA, voffA);
            PG8_WAIT_V(8); PG8_WAIT_L(0); PG8_BAR; PG8_MMA(0, 0, At, B0); PG8_MMA(0, 1, At, B1); PG8_BAR; PG8_SCHED;
            PG8_LDA(At, 1, 1); PG8_STAGE(PG8_SB(1, 0), b3, voffB); PG8_STAGE(PG8_SB(1, 1), b3 + hstepB, voffB); PG8_STAGE(PG8_SA(1, 0), a3, voffA);
            PG8_WAIT_V(8); PG8_WAIT_L(0); PG8_BAR; PG8_MMA(1, 0, At, B0); PG8_MMA(1, 1, At, B1); PG8_BAR; PG8_SCHED;
#else
            PG8_LDB(B0, 0, 0); PG8_SCHED; PG8_LDA(At, 0, 0); PG8_STAGE(PG8_SA(1, 1), a1 + hstepA, voffA);
            PG8_WAIT_L(8); PG8_BAR; PG8_WAIT_L(0); PG8_MMA(0, 0, At, B0); PG8_BAR; PG8_SCHED;
            PG8_LDB(B1, 0, 1); PG8_STAGE(PG8_SB(0, 0), b2, voffB);
            PG8_BAR; PG8_WAIT_L(0); PG8_MMA(0, 1, At, B1); PG8_BAR;
            PG8_LDA(At, 0, 1); PG8_STAGE(PG8_SA(0, 0), a2, voffA);
            PG8_BAR; PG8_WAIT_L(0); PG8_MMA(1, 0, At, B0); PG8_BAR; PG8_SCHED;
            PG8_STAGE(PG8_SB(0, 1), b2 + hstepB, voffB);
            PG8_WAIT_V(6); PG8_BAR; PG8_MMA(1, 1, At, B1); PG8_BAR;
            PG8_LDB(B0, 1, 0); PG8_SCHED; PG8_LDA(At, 1, 0); PG8_STAGE(PG8_SA(0, 1), a2 + hstepA, voffA);
            PG8_WAIT_L(8); PG8_BAR; PG8_WAIT_L(0); PG8_MMA(0, 0, At, B0); PG8_BAR; PG8_SCHED;
            PG8_LDB(B1, 1, 1); PG8_STAGE(PG8_SB(1, 0), b3, voffB);
            PG8_BAR; PG8_WAIT_L(0); PG8_MMA(0, 1, At, B1); PG8_BAR;
            PG8_LDA(At, 1, 1); PG8_STAGE(PG8_SA(1, 0), a3, voffA);
            PG8_BAR; PG8_WAIT_L(0); PG8_MMA(1, 0, At, B0); PG8_BAR; PG8_SCHED;
            PG8_STAGE(PG8_SB(1, 1), b3 + hstepB, voffB);
            PG8_WAIT_V(6); PG8_BAR; PG8_MMA(1, 1, At, B1); PG8_BAR;
#endif
        }
        if (wr == 0) PG8_BAR;
        { int ln_; asm volatile("v_mbcnt_lo_u32_b32 %0, -1, 0\n\tv_mbcnt_hi_u32_b32 %0, -1, %0" : "=v"(ln_)); E(acc, cur, lds, wr, wc, ln_ & 15, ln_ >> 4); }
        if (!has_next) break;
        { float zz; asm volatile("v_mov_b32 %0, 0" : "=v"(zz));
#pragma unroll
        for (int a = 0; a < 2; ++a)
#pragma unroll
            for (int b = 0; b < 2; ++b)
#pragma unroll
                for (int m = 0; m < 4; ++m)
#pragma unroll
                    for (int n = 0; n < 2; ++n) acc[a][b][m][n] = (f32x4){zz, zz, zz, zz}; }
        cur = nxt; cA = nA; cB = nB; ++ui;
        if (wr == 1) PG8_BAR;
    }
    PG8_WAIT_V(0);
    PG8_BAR;
#undef PG8_SA
#undef PG8_SB
#undef PG8_STAGE
#undef PG8_LDA
#undef PG8_LDB
#undef PG8_MMA
#undef PG8_WAIT_V
#undef PG8_WAIT_L
#undef PG8_BAR
#undef PG8_SCHED
}

#define EROW(ai, m) (128 * (ai) + 64 * wr + 16 * (m) + fr)
#define ECOL(bj) (128 * (bj) + 32 * wc + 8 * fq)
__device__ __forceinline__ float row_rs(const float* ssq, int row, int fq) {
    const f32x4 v = *(const f32x4*)(ssq + (size_t)row * 16 + 4 * fq); float s = (v.x + v.y) + (v.z + v.w);
    s += __shfl_xor(s, 16); s += __shfl_xor(s, 32);
    return rsqrtf(s * (1.f / 1024.f) + EPS);
}
__device__ __forceinline__ u32x4 pack8(const f32x4 a, const f32x4 b) { u32x4 w; w.x = cvt_pk_bf16(a[0], a[1]); w.y = cvt_pk_bf16(a[2], a[3]); w.z = cvt_pk_bf16(b[0], b[1]); w.w = cvt_pk_bf16(b[2], b[3]); return w; }

struct EpiStore { int ldc;
    __device__ __forceinline__ void operator()(AccT& acc, const Unit& u, LAS unsigned char*, int wr, int wc, int fr, int fq) const {
#pragma unroll
        for (int ai = 0; ai < 2; ++ai)
#pragma unroll
            for (int m = 0; m < 4; ++m) { bf16_t* rp = u.O + (size_t)EROW(ai, m) * ldc;
#pragma unroll
                for (int bj = 0; bj < 2; ++bj) *(u32x4*)(rp + ECOL(bj)) = pack8(acc[ai][bj][m][0], acc[ai][bj][m][1]); }
    }
};
struct EpiProj { bf16_t* proj; float* dt; const float* ssq;
    __device__ __forceinline__ void operator()(AccT& acc, const Unit& u, LAS unsigned char*, int wr, int wc, int fr, int fq) const {
#pragma unroll
        for (int ai = 0; ai < 2; ++ai)
#pragma unroll
            for (int m = 0; m < 4; ++m) { const int row = u.pm * 256 + EROW(ai, m); const float rs = row_rs(ssq, row, fq);
                if (u.pn < 11) {
#pragma unroll
                    for (int bj = 0; bj < 2; ++bj) *(u32x4*)(proj + (size_t)row * PLD + u.pn * 256 + ECOL(bj)) = pack8(acc[ai][bj][m][0] * rs, acc[ai][bj][m][1] * rs);
                } else if (wc == 0 && fq < 2) {
                    *(f32x4*)(dt + (size_t)row * 16 + 8 * fq) = acc[ai][0][m][0] * rs; *(f32x4*)(dt + (size_t)row * 16 + 8 * fq + 4) = acc[ai][0][m][1] * rs;
                } }
    }
};
struct EpiRes { bf16_t* xb; float* ssq; const float* rsd;
    __device__ __forceinline__ void operator()(AccT& acc, const Unit& u, LAS unsigned char*, int wr, int wc, int fr, int fq) const {
#pragma unroll
        for (int ai = 0; ai < 2; ++ai)
#pragma unroll
            for (int m = 0; m < 4; ++m) { const int row = u.pm * 256 + EROW(ai, m); float s = 0.f; const float rsc = rsd ? rsd[(size_t)row * 2] : 1.f;
#pragma unroll
                for (int bj = 0; bj < 2; ++bj) { const size_t off = (size_t)row * D + u.pn * 256 + ECOL(bj); acc[ai][bj][m][0] *= rsc; acc[ai][bj][m][1] *= rsc;
                    const u32x4 xo = *(const u32x4*)(xb + off);
                    const f32x4 a = (f32x4){bflo(xo.x), bfhi(xo.x), bflo(xo.y), bfhi(xo.y)} + acc[ai][bj][m][0], b = (f32x4){bflo(xo.z), bfhi(xo.z), bflo(xo.w), bfhi(xo.w)} + acc[ai][bj][m][1];
                    *(u32x4*)(xb + off) = pack8(a, b);
                    s += (a[0] * a[0] + a[1] * a[1]) + (a[2] * a[2] + a[3] * a[3]) + (b[0] * b[0] + b[1] * b[1]) + (b[2] * b[2] + b[3] * b[3]); }
                s += __shfl_xor(s, 16); s += __shfl_xor(s, 32);
                if (fq == 0) ssq[(size_t)row * 16 + u.pn * 4 + wc] = s; }
    }
};
struct EpiSoftmax { bf16_t* P; const float* ssq;
    __device__ __forceinline__ void operator()(AccT& acc, const Unit& u, LAS unsigned char* lds, int wr, int wc, int fr, int fq) const {
        LAS f32x2* tab = (LAS f32x2*)(lds + SPARE_OFF);
        float mown[2][4];
#pragma unroll
        for (int ai = 0; ai < 2; ++ai)
#pragma unroll
            for (int m = 0; m < 4; ++m) { const int rl = EROW(ai, m); const float rs = row_rs(ssq, u.pm * 256 + rl, fq); float mx = -3.0e38f;
#pragma unroll
                for (int bj = 0; bj < 2; ++bj)
#pragma unroll
                    for (int n = 0; n < 2; ++n) { acc[ai][bj][m][n] *= rs; const f32x4 v = acc[ai][bj][m][n]; mx = fmaxf(mx, fmaxf(fmaxf(v[0], v[1]), fmaxf(v[2], v[3]))); }
                mx = fmaxf(mx, __shfl_xor(mx, 16)); mx = fmaxf(mx, __shfl_xor(mx, 32)); float l = 0.f;
#pragma unroll
                for (int bj = 0; bj < 2; ++bj)
#pragma unroll
                    for (int n = 0; n < 2; ++n) { f32x4 v = acc[ai][bj][m][n]; v[0] = __expf(v[0] - mx); v[1] = __expf(v[1] - mx); v[2] = __expf(v[2] - mx); v[3] = __expf(v[3] - mx); acc[ai][bj][m][n] = v; l += (v[0] + v[1]) + (v[2] + v[3]); }
                l += __shfl_xor(l, 16); l += __shfl_xor(l, 32); mown[ai][m] = mx;
                if (fq == 0) tab[rl * 4 + wc] = (f32x2){mx, l}; }
        asm volatile("s_waitcnt lgkmcnt(0)" ::: "memory"); __builtin_amdgcn_s_barrier(); asm volatile("" ::: "memory");
#pragma unroll
        for (int ai = 0; ai < 2; ++ai)
#pragma unroll
            for (int m = 0; m < 4; ++m) { const int rl = EROW(ai, m); const f32x2 t0 = tab[rl * 4 + 0], t1 = tab[rl * 4 + 1], t2 = tab[rl * 4 + 2], t3 = tab[rl * 4 + 3];
                const float M = fmaxf(fmaxf(t0.x, t1.x), fmaxf(t2.x, t3.x));
                const float Lsum = t0.y * __expf(t0.x - M) + t1.y * __expf(t1.x - M) + t2.y * __expf(t2.x - M) + t3.y * __expf(t3.x - M);
                const float f = __expf(mown[ai][m] - M) / Lsum;
                bf16_t* rp = P + (size_t)(u.pm * 256 + rl) * D + u.pn * 256;
#pragma unroll
                for (int bj = 0; bj < 2; ++bj) *(u32x4*)(rp + ECOL(bj)) = pack8(acc[ai][bj][m][0] * f, acc[ai][bj][m][1] * f); }
        asm volatile("s_waitcnt lgkmcnt(0)" ::: "memory"); __builtin_amdgcn_s_barrier(); asm volatile("" ::: "memory");
    }
};
struct EpiUp { bf16_t* act; float* gf; float* vf; float* gl; const float* ssq; const float* cw; const float* cb;
    __device__ __forceinline__ void operator()(AccT& acc, const Unit& u, LAS unsigned char*, int wr, int wc, int fr, int fq) const {
        const int ch = u.pn * 128 + 32 * wc + 8 * fq;
        f32x4 w0[2], w1[2], w2[2], bb[2];
#pragma unroll
        for (int n = 0; n < 2; ++n) { w0[n] = *(const f32x4*)(cw + ch + 4 * n); w1[n] = *(const f32x4*)(cw + DFF + ch + 4 * n); w2[n] = *(const f32x4*)(cw + 2 * DFF + ch + 4 * n); bb[n] = *(const f32x4*)(cb + ch + 4 * n); }
#pragma unroll
        for (int ai = 0; ai < 2; ++ai) {
            float rs[4];
#pragma unroll
            for (int m = 0; m < 4; ++m) rs[m] = row_rs(ssq, u.pm * 256 + EROW(ai, m), fq);
#pragma unroll
            for (int m = 0; m < 4; ++m)
#pragma unroll
                for (int n = 0; n < 2; ++n) { acc[ai][0][m][n] *= rs[m]; acc[ai][1][m][n] *= rs[m]; }
            const int q = u.pm * 4 + ai * 2 + wr;
#pragma unroll
            for (int m = 0; m < 4; ++m) { const int row = u.pm * 256 + EROW(ai, m);
                f32x4 o[2];
#pragma unroll
                for (int n = 0; n < 2; ++n)
#pragma unroll
                    for (int j = 0; j < 4; ++j) { const float g0 = acc[ai][0][m][n][j]; const float pv = (m > 0) ? acc[ai][0][m > 0 ? m - 1 : 0][n][j] : 0.f;
                        const float g1 = dpp_prev1(g0, pv), g2 = dpp_prev2(g0, pv);
                        const float gc = __builtin_fmaf(w0[n][j], g2, __builtin_fmaf(w1[n][j], g1, __builtin_fmaf(w2[n][j], g0, bb[n][j])));
                        o[n][j] = silu_f(gc) * acc[ai][1][m][n][j]; }
                if (m == 0 && fr < 2) {
                    const size_t so = ((size_t)q * 2 + fr) * DFF + ch;
                    *(f32x4*)(gf + so) = acc[ai][0][0][0]; *(f32x4*)(gf + so + 4) = acc[ai][0][0][1];
                    *(f32x4*)(vf + so) = acc[ai][1][0][0]; *(f32x4*)(vf + so + 4) = acc[ai][1][0][1];
                } else {
                    *(u32x4*)(act + (size_t)row * DFF + ch) = pack8(o[0], o[1]);
                }
                if (m == 3 && fr >= 14) { const size_t so = ((size_t)q * 2 + (fr - 14)) * DFF + ch;
                    *(f32x4*)(gl + so) = acc[ai][0][3][0]; *(f32x4*)(gl + so + 4) = acc[ai][0][3][1]; }
            }
        }
    }
};
struct EpiS5A { bf16_t* ypre; float* hloc;
    __device__ __forceinline__ void operator()(AccT& acc, const Unit& u, LAS unsigned char*, int wr, int wc, int fr, int fq) const {
        const int g = u.z;
#pragma unroll
        for (int ai = 0; ai < 2; ++ai)
#pragma unroll
            for (int m = 0; m < 4; ++m) { const int chunk = u.pm * 256 + EROW(ai, m);
                if (u.pn < 2) {
#pragma unroll
                    for (int bj = 0; bj < 2; ++bj) { const int qc = u.pn * 256 + ECOL(bj), t = qc >> 4, c = qc & 15;
                        *(u32x4*)(ypre + ((size_t)chunk * 32 + t) * 256 + 16 * g + c) = pack8(acc[ai][bj][m][0], acc[ai][bj][m][1]); }
                } else {
                    float* hp = hloc + ((size_t)chunk * 16 + g) * 128 + ECOL(0);
                    *(f32x4*)hp = acc[ai][0][m][0]; *(f32x4*)(hp + 4) = acc[ai][0][m][1];
                } }
    }
};
struct EpiS5B { const bf16_t* ypre; bf16_t* yg;
    __device__ __forceinline__ void operator()(AccT& acc, const Unit& u, LAS unsigned char*, int wr, int wc, int fr, int fq) const {
        const int g = u.z;
#pragma unroll
        for (int ai = 0; ai < 2; ++ai)
#pragma unroll
            for (int m = 0; m < 4; ++m) { const int chunk = u.pm * 256 + EROW(ai, m);
#pragma unroll
                for (int bj = 0; bj < 2; ++bj) { const int qc = u.pn * 256 + ECOL(bj), t = qc >> 4, c = qc & 15; const size_t off = ((size_t)chunk * 32 + t) * 256 + 16 * g + c;
                    const u32x4 p = *(const u32x4*)(ypre + off); f32x4 a = acc[ai][bj][m][0], b = acc[ai][bj][m][1];
                    a[0] = gelu_tanh(a[0] + bflo(p.x)); a[1] = gelu_tanh(a[1] + bfhi(p.x)); a[2] = gelu_tanh(a[2] + bflo(p.y)); a[3] = gelu_tanh(a[3] + bfhi(p.y));
                    b[0] = gelu_tanh(b[0] + bflo(p.z)); b[1] = gelu_tanh(b[1] + bfhi(p.z)); b[2] = gelu_tanh(b[2] + bflo(p.w)); b[3] = gelu_tanh(b[3] + bfhi(p.w));
                    *(u32x4*)(yg + off) = pack8(a, b); } }
    }
};
struct EpiGlu { const bf16_t* yg; bf16_t* ycat; const float* rsd;
    __device__ __forceinline__ void operator()(AccT& acc, const Unit& u, LAS unsigned char*, int wr, int wc, int fr, int fq) const {
#pragma unroll
        for (int ai = 0; ai < 2; ++ai)
#pragma unroll
            for (int m = 0; m < 4; ++m) { const int row = u.pm * 256 + EROW(ai, m); const float irs = rsd[(size_t)row * 2 + 1];
#pragma unroll
                for (int bj = 0; bj < 2; ++bj) { const int c = ECOL(bj); const u32x4 p = *(const u32x4*)(yg + (size_t)row * 256 + c); f32x4 a = acc[ai][bj][m][0], b = acc[ai][bj][m][1];
                    a[0] = bflo(p.x) * sigmoid_f(a[0]); a[1] = bfhi(p.x) * sigmoid_f(a[1]); a[2] = bflo(p.y) * sigmoid_f(a[2]); a[3] = bfhi(p.y) * sigmoid_f(a[3]);
                    b[0] = bflo(p.z) * sigmoid_f(b[0]); b[1] = bfhi(p.z) * sigmoid_f(b[1]); b[2] = bflo(p.w) * sigmoid_f(b[2]); b[3] = bfhi(p.w) * sigmoid_f(b[3]);
                    *(u32x4*)(ycat + (size_t)row * D + c) = pack8(a * irs, b * irs); } }
    }
};

struct Args { const float* in[32]; float* out; unsigned char* ws; int dupm; int sync2; };
typedef const Args __attribute__((address_space(4))) CArgs;
struct Frame { LAS unsigned char* lds; int tid, lane, wave, G, wg; unsigned char* ws; float* out; };

__device__ __forceinline__ void tr_item(const float* W, int K, int N, bf16_t* WT, const float* kscale, int upmap, LAS float* scr, int item, int nblk, int lane) {
    const int kb = item / nblk, nb = item % nblk, k0 = 64 * kb, n0 = 32 * nb;
    const int c4 = (lane & 7) * 4, rr = lane >> 3;
    f32x4 v[8];
#pragma unroll
    for (int i = 0; i < 8; ++i) { const int kk = 8 * i + rr; v[i] = (n0 + c4 < N) ? *(const f32x4*)(W + (size_t)(k0 + kk) * N + n0 + c4) : (f32x4){0.f, 0.f, 0.f, 0.f}; }
#pragma unroll
    for (int i = 0; i < 8; ++i) { const int kk = 8 * i + rr; const float sc = kscale ? kscale[k0 + kk] : 1.f; LAS float* d = scr + kk * 33 + c4;
        d[0] = v[i][0] * sc; d[1] = v[i][1] * sc; d[2] = v[i][2] * sc; d[3] = v[i][3] * sc; }
    asm volatile("s_waitcnt lgkmcnt(0)" ::: "memory");
    int d0 = n0;
    if (upmap) d0 = (n0 < DFF) ? (n0 / 128) * 256 + (n0 % 128) : ((n0 - DFF) / 128) * 256 + 128 + ((n0 - DFF) % 128);
    const int c = lane & 7;
#pragma unroll
    for (int j = 0; j < 4; ++j) { const int n = (lane >> 3) + 8 * j; const LAS float* sp = scr + (8 * c) * 33 + n;
        u32x4 o; o.x = cvt_pk_bf16(sp[0 * 33], sp[1 * 33]); o.y = cvt_pk_bf16(sp[2 * 33], sp[3 * 33]); o.z = cvt_pk_bf16(sp[4 * 33], sp[5 * 33]); o.w = cvt_pk_bf16(sp[6 * 33], sp[7 * 33]);
        *(u32x4*)(WT + (size_t)(d0 + n) * K + k0 + 8 * c) = o; }
    asm volatile("s_waitcnt lgkmcnt(0)" ::: "memory");
}

__device__ __forceinline__ void s5_build(CArgs* args, Frame& F, int l, int g, int q) {
    LAS float* apr = (LAS float*)(F.lds);
    LAS float* api = apr + 33 * 65;
    LAS float* bbr = api + 33 * 65;
    LAS float* bbi = bbr + 64 * 16;
    LAS float* crr = bbi + 64 * 16;
    LAS float* cii = crr + 16 * 65;
    LAS float* km = cii + 16 * 65 + 2;
    LAS float* dd = km + 32 * 264;
    const float* lam_re = args->in[4] + ((size_t)l * 16 + g) * 64; const float* lam_im = args->in[5] + ((size_t)l * 16 + g) * 64;
    const float dt = __expf(args->in[6][l * 16 + g]);
    const float* b_re = args->in[7] + ((size_t)l * 16 + g) * 64 * 16; const float* b_im = args->in[8] + ((size_t)l * 16 + g) * 64 * 16;
    const float* c_re = args->in[9] + ((size_t)l * 16 + g) * 16 * 64; const float* c_im = args->in[10] + ((size_t)l * 16 + g) * 16 * 64;
    const float* dsk = args->in[11] + (size_t)l * 256 + g * 16;
    const int tid = F.tid;
    if (tid < 64) { const int p = tid; const float lr = fminf(lam_re[p], -1e-4f), li = lam_im[p];
        for (int j = 0; j <= 32; ++j) { const float mag = __expf((float)j * lr * dt); float sn, cs; sincos_rev((float)j * li * dt, sn, cs); apr[j * 65 + p] = mag * cs; api[j * 65 + p] = mag * sn; }
        const float mag = __expf(lr * dt); float sn, cs; sincos_rev(li * dt, sn, cs); const float are = mag * cs, aim = mag * sn, den = lr * lr + li * li;
        const float fre = ((are - 1.f) * lr + aim * li) / den, fim = (aim * lr - (are - 1.f) * li) / den;
        for (int c = 0; c < 16; ++c) { const float br = b_re[p * 16 + c], bi = b_im[p * 16 + c]; bbr[p * 16 + c] = fre * br - fim * bi; bbi[p * 16 + c] = fre * bi + fim * br; } }
    for (int i = tid; i < 1024; i += 512) { crr[(i >> 6) * 65 + (i & 63)] = c_re[i]; cii[(i >> 6) * 65 + (i & 63)] = c_im[i]; }
    if (tid < 16) dd[tid] = dsk[tid];
    __syncthreads();
    { const int j = tid >> 4, c = tid & 15; float sacc[16];
#pragma unroll
      for (int c2 = 0; c2 < 16; ++c2) sacc[c2] = 0.f;
      for (int p = 0; p < 64; ++p) { const float cr = crr[c * 65 + p], ci = cii[c * 65 + p], ar = apr[j * 65 + p], ai = api[j * 65 + p]; const float xr = cr * ar - ci * ai, xi = cr * ai + ci * ar;
#pragma unroll
          for (int c2 = 0; c2 < 16; ++c2) sacc[c2] += xr * bbr[p * 16 + c2] - xi * bbi[p * 16 + c2]; }
#pragma unroll
      for (int c2 = 0; c2 < 16; ++c2) km[j * 264 + c * 16 + c2] = sacc[c2]; }
    __syncthreads();
    bf16_t* A = (bf16_t*)(F.ws + WS_S5A) + (size_t)g * 768 * 512; bf16_t* B = (bf16_t*)(F.ws + WS_S5B) + (size_t)g * 512 * 256;
    for (int v = q * 192 * 64 + tid; v < (q + 1) * 192 * 64; v += 512) { const int row = v >> 6, col0 = (v & 63) * 8, s = col0 >> 4, c0 = col0 & 15; float o[8];
        if (row < 512) { const int t = row >> 4, c = row & 15;
#pragma unroll
            for (int e = 0; e < 8; ++e) o[e] = 0.f;
            if (s <= t) { const f32x4 k0v = *(const LAS f32x4*)(km + (t - s) * 264 + c * 16 + c0), k1v = *(const LAS f32x4*)(km + (t - s) * 264 + c * 16 + c0 + 4);
                o[0] = k0v[0]; o[1] = k0v[1]; o[2] = k0v[2]; o[3] = k0v[3]; o[4] = k1v[0]; o[5] = k1v[1]; o[6] = k1v[2]; o[7] = k1v[3];
#pragma unroll
                for (int e = 0; e < 8; ++e) if (s == t && c0 + e == c) o[e] += dd[c]; }
        } else if (row < 640) { const int q = row - 512, p = q & 63, im = q >> 6; const float ar = apr[(31 - s) * 65 + p], ai = api[(31 - s) * 65 + p];
#pragma unroll
            for (int e = 0; e < 8; ++e) { const float br = bbr[p * 16 + c0 + e], bi = bbi[p * 16 + c0 + e]; o[e] = im ? (ar * bi + ai * br) : (ar * br - ai * bi); }
        } else { *(u32x4*)(A + (size_t)row * 512 + col0) = (u32x4){0u, 0u, 0u, 0u}; continue; }
        u32x4 w; w.x = cvt_pk_bf16(o[0], o[1]); w.y = cvt_pk_bf16(o[2], o[3]); w.z = cvt_pk_bf16(o[4], o[5]); w.w = cvt_pk_bf16(o[6], o[7]);
        *(u32x4*)(A + (size_t)row * 512 + col0) = w; }
    for (int v = q * 128 * 32 + tid; v < (q + 1) * 128 * 32; v += 512) { const int row = v >> 5, k0 = (v & 31) * 8, t = row >> 4, c = row & 15; float o[8];
#pragma unroll
        for (int e = 0; e < 8; ++e) { const int k = k0 + e; float x = 0.f;
            if (k < 64) x = crr[c * 65 + k] * apr[(t + 1) * 65 + k] - cii[c * 65 + k] * api[(t + 1) * 65 + k];
            else if (k < 128) { const int p = k - 64; x = -(crr[c * 65 + p] * api[(t + 1) * 65 + p] + cii[c * 65 + p] * apr[(t + 1) * 65 + p]); }
            o[e] = x; }
        u32x4 w; w.x = cvt_pk_bf16(o[0], o[1]); w.y = cvt_pk_bf16(o[2], o[3]); w.z = cvt_pk_bf16(o[4], o[5]); w.w = cvt_pk_bf16(o[6], o[7]);
        *(u32x4*)(B + (size_t)row * 256 + k0) = w; }
    __syncthreads();
}

__device__ __forceinline__ void attn_prep(CArgs* args, Frame& F) {
    LAS float* scr = (LAS float*)(F.lds + F.wave * 8448);
    const int gw = F.wg * 8 + F.wave, NGW = F.G * 8;
    for (int it = gw; it < 4 * 3 * 512; it += NGW) { const int l = it / 1536, r = it % 1536, wsel = r / 512, item = r % 512;
        unsigned char* tb = F.ws + WS_TMP + (size_t)l * TMP_L;
        const float* src = args->in[wsel == 0 ? 23 : (wsel == 1 ? 24 : 25)] + (size_t)l * D * D;
        tr_item(src, D, D, (bf16_t*)(tb + (wsel == 0 ? 2 : (wsel == 1 ? 4 : 6)) * MiB), nullptr, 0, scr, item, 32, F.lane); }
    for (int v = F.wg * 512 + F.tid; v < 4 * D * D / 8; v += F.G * 512) { const int l = v >> 17, vv = v & 131071, d = vv >> 7; const float* wq = args->in[22] + (size_t)l * D * D;
        const float sc = args->in[20][l * D + d] * 0.0625f; const f32x4 a = *(const f32x4*)(wq + (size_t)vv * 8) * sc, b = *(const f32x4*)(wq + (size_t)vv * 8 + 4) * sc;
        *(u32x4*)((bf16_t*)(F.ws + WS_TMP + (size_t)l * TMP_L) + (size_t)vv * 8) = pack8(a, b); }
    for (int mm = gw; mm < 4 * 512; mm += NGW) { const int l = mm >> 9, m = mm & 511; const float* mr = args->in[1] + (size_t)m * D; const float* memw = args->in[21] + l * D; f32x4 v[4]; float s = 0.f;
#pragma unroll
        for (int j = 0; j < 4; ++j) { v[j] = *(const f32x4*)(mr + 4 * F.lane + 256 * j); s += (v[j][0] * v[j][0] + v[j][1] * v[j][1]) + (v[j][2] * v[j][2] + v[j][3] * v[j][3]); }
        const float rs = rsqrtf(wave_sum(s) * (1.f / D) + EPS); bf16_t* o = (bf16_t*)(F.ws + WS_TMP + (size_t)l * TMP_L + 8 * MiB) + (size_t)m * D;
#pragma unroll
        for (int j = 0; j < 4; ++j) { const f32x4 w = *(const f32x4*)(memw + 4 * F.lane + 256 * j); u32x2 p; p.x = cvt_pk_bf16(v[j][0] * rs * w[0], v[j][1] * rs * w[1]); p.y = cvt_pk_bf16(v[j][2] * rs * w[2], v[j][3] * rs * w[3]);
            *(u32x2*)(o + 4 * F.lane + 256 * j) = p; } }
    {
        float* ssq = (float*)(F.ws + WS_SSQ); bf16_t* xb = (bf16_t*)(F.ws + WS_XB);
        for (int m = gw; m < T; m += NGW) { const float* xr = args->in[0] + (size_t)m * D; f32x4 v[4]; float s = 0.f;
#pragma unroll
            for (int j = 0; j < 4; ++j) { v[j] = *(const f32x4*)(xr + 4 * F.lane + 256 * j); s += (v[j][0] * v[j][0] + v[j][1] * v[j][1]) + (v[j][2] * v[j][2] + v[j][3] * v[j][3]); }
            s = wave_sum(s);
#pragma unroll
            for (int j = 0; j < 4; ++j) { u32x2 p; p.x = cvt_pk_bf16(v[j][0], v[j][1]); p.y = cvt_pk_bf16(v[j][2], v[j][3]); *(u32x2*)(xb + (size_t)m * D + 4 * F.lane + 256 * j) = p; }
            if (F.lane < 16) ssq[(size_t)m * 16 + F.lane] = (F.lane == 0) ? s : 0.f; } }
}
__device__ __forceinline__ void prep_phase(CArgs* args, Frame& F, int l, int what) {
    if (!(what & 1)) return;
    if (F.wg >= F.G - 64) { s5_build(args, F, l, (F.wg - (F.G - 64)) >> 2, (F.wg - (F.G - 64)) & 3); return; }
    LAS float* scr = (LAS float*)(F.lds + F.wave * 8448);
    const int gw = F.wg * 8 + F.wave, NGW = (F.G - 64) * 8;
    const float* w_in = args->in[3] + (size_t)l * D * INC; const float* w_out = args->in[19] + (size_t)l * D * D;
    const float* w_up = args->in[27] + (size_t)l * D * 2 * DFF; const float* w_down = args->in[30] + (size_t)l * DFF * D; const float* w_glu = args->in[12] + (size_t)l * 256 * 256;
    const float* mixw = args->in[2] + l * D; const float* ffw = args->in[26] + l * D; const float* ssdnw = args->in[18] + l * 768;
    constexpr int I_IN = 16 * 96, I_OUT = 16 * 32, I_UP = 16 * 176, I_DN = 44 * 32, I_GLU = 4 * 8;
    constexpr int NITEMS = I_IN + I_OUT + I_UP + I_DN + I_GLU;
    for (int it = gw; it < NITEMS; it += NGW) {
        int r = it;
        if (r < I_IN) { tr_item(w_in, D, INC, (bf16_t*)(F.ws + WS_WIN), mixw, 0, scr, r, 96, F.lane); continue; } r -= I_IN;
        if (r < I_OUT) { const int kb = r / 32, k0 = 64 * kb; tr_item(w_out, D, D, (bf16_t*)(F.ws + WS_WOUT), k0 >= 256 ? ssdnw - 256 : nullptr, 0, scr, r, 32, F.lane); continue; } r -= I_OUT;
        if (r < I_UP) { tr_item(w_up, D, 2 * DFF, (bf16_t*)(F.ws + WS_WUP), ffw, 1, scr, r, 176, F.lane); continue; } r -= I_UP;
        if (r < I_DN) { tr_item(w_down, DFF, D, (bf16_t*)(F.ws + WS_WDOWN), nullptr, 0, scr, r, 32, F.lane); continue; } r -= I_DN;
        tr_item(w_glu, 256, 256, (bf16_t*)(F.ws + WS_WGLU), nullptr, 0, scr, r, 8, F.lane);
    }
}

constexpr int SP = 272;
__device__ __forceinline__ void ssd_tables(CArgs* args, Frame& F, int l, int chunk, LAS float* dtv, LAS float* acs) {
    const float* DT = (const float*)(F.ws + WS_DT) + (size_t)chunk * 128 * 16;
    for (int h = F.wave; h < 12; h += 8) { const float bias = args->in[15][l * 12 + h], a = -__expf(args->in[16][l * 12 + h]);
        float x0 = DT[(size_t)F.lane * 16 + h] + bias, x1 = DT[(size_t)(F.lane + 64) * 16 + h] + bias;
        const float d0 = softplus_f(x0), d1 = softplus_f(x1);
        float s0 = d0 * a, s1 = d1 * a;
#pragma unroll
        for (int o = 1; o < 64; o <<= 1) { const float t0 = __shfl_up(s0, o), t1 = __shfl_up(s1, o); if (F.lane >= o) { s0 += t0; s1 += t1; } }
        s1 += __shfl(s0, 63);
        dtv[h * 128 + F.lane] = d0; dtv[h * 128 + F.lane + 64] = d1; acs[h * 128 + F.lane] = s0; acs[h * 128 + F.lane + 64] = s1; }
}
__device__ __forceinline__ void ssd_conv_load(Frame& F, int chunk, int l0, int xcol, u32x4 (&xr)[11]) {
    const bf16_t* proj = (const bf16_t*)(F.ws + WS_PROJ);
    const bool bstart = (chunk & 127) == 0;
#pragma unroll
    for (int r = 0; r < 11; ++r) { const int lr = l0 + r - 3; const bool ok = (lr >= 0) || !bstart;
        xr[r] = ok ? *(const u32x4*)(proj + (size_t)(chunk * 128 + lr) * PLD + 1024 + xcol) : (u32x4){0u, 0u, 0u, 0u}; }
}
template <bool TR>
__device__ __forceinline__ void ssd_conv_math(CArgs* args, int l, int l0, int xcol, const LAS float* sc, const u32x4 (&xr)[11], u32x4 (&o)[8]) {
    const float* cw = args->in[13] + (size_t)l * 4 * 1792 + xcol; const float* cbp = args->in[14] + (size_t)l * 1792 + xcol;
    float scv[8];
#pragma unroll
    for (int i = 0; i < 8; ++i) scv[i] = (TR && sc) ? sc[l0 + i] : 1.f;
    const f32x4 W0[2] = {*(const f32x4*)cw, *(const f32x4*)(cw + 4)}, W1[2] = {*(const f32x4*)(cw + 1792), *(const f32x4*)(cw + 1796)}, W2[2] = {*(const f32x4*)(cw + 3584), *(const f32x4*)(cw + 3588)},
                W3[2] = {*(const f32x4*)(cw + 5376), *(const f32x4*)(cw + 5380)}, BV[2] = {*(const f32x4*)cbp, *(const f32x4*)(cbp + 4)};
#pragma unroll
    for (int jp = 0; jp < 4; ++jp) { float ya[8], yb[8];
#pragma unroll
        for (int hh = 0; hh < 2; ++hh) { const int j = 2 * jp + hh; const float w0 = W0[j >> 2][j & 3], w1 = W1[j >> 2][j & 3], w2 = W2[j >> 2][j & 3], w3 = W3[j >> 2][j & 3], bsv = BV[j >> 2][j & 3]; float x[11];
#pragma unroll
            for (int r = 0; r < 11; ++r) { const unsigned wd = xr[r][jp]; x[r] = hh ? bfhi(wd) : bflo(wd); }
#pragma unroll
            for (int i = 0; i < 8; ++i) { const float y = silu_f(__builtin_fmaf(w3, x[i + 3], __builtin_fmaf(w2, x[i + 2], __builtin_fmaf(w1, x[i + 1], __builtin_fmaf(w0, x[i], bsv))))) * scv[i]; if (hh) yb[i] = y; else ya[i] = y; } }
        if (TR) { o[2 * jp].x = cvt_pk_bf16(ya[0], ya[1]); o[2 * jp].y = cvt_pk_bf16(ya[2], ya[3]); o[2 * jp].z = cvt_pk_bf16(ya[4], ya[5]); o[2 * jp].w = cvt_pk_bf16(ya[6], ya[7]);
                  o[2 * jp + 1].x = cvt_pk_bf16(yb[0], yb[1]); o[2 * jp + 1].y = cvt_pk_bf16(yb[2], yb[3]); o[2 * jp + 1].z = cvt_pk_bf16(yb[4], yb[5]); o[2 * jp + 1].w = cvt_pk_bf16(yb[6], yb[7]); }
        else {
#pragma unroll
            for (int i = 0; i < 8; ++i) o[i][jp] = cvt_pk_bf16(ya[i], yb[i]); } }
}
__device__ __forceinline__ void ssd_s1(CArgs* args, Frame& F, int l) {
    LAS unsigned char* XT = F.lds;
    LAS unsigned char* BT = F.lds + 192 * SP;
    LAS float* dtv = (LAS float*)(F.lds + 320 * SP);
    LAS float* acs = dtv + 12 * 128;
    LAS float* scl = acs + 12 * 128;
    const int fr = F.lane & 15, fq = F.lane >> 4, w = F.wave;
    bf16_t* ST = (bf16_t*)(F.ws + WS_ST); float* CDp = (float*)(F.ws + WS_CD); bf16_t* xp = (bf16_t*)F.out;
    for (int chunk = F.wg; chunk < 256; chunk += F.G) {
        __syncthreads();
        ssd_tables(args, F, l, chunk, dtv, acs);
        __syncthreads();
        for (int i = F.tid; i < 12 * 128; i += 512) { const int h = i >> 7; scl[i] = dtv[i] * __expf(acs[h * 128 + 127] - acs[i]); }
        if (F.tid < 12) CDp[chunk * 16 + F.tid] = __expf(acs[F.tid * 128 + 127]);
        __syncthreads();
        for (int g = 0; g < 4; ++g) {
            for (int id = F.tid; id < 40 * 16; id += 512) { const int rb = id & 15, cbk = id >> 4, l0 = rb * 8; u32x4 o[8], xa[11];
                const int xcol = (cbk < 24) ? 192 * g + cbk * 8 : 768 + 128 * g + (cbk - 24) * 8;
                ssd_conv_load(F, chunk, l0, xcol, xa);
                if (cbk < 24) { const int hp0 = cbk * 8; const int h = 3 * g + (hp0 >> 6); ssd_conv_math<true>(args, l, l0, xcol, scl + h * 128, xa, o);
#pragma unroll
                    for (int j = 0; j < 8; ++j) *(LAS u32x4*)(XT + (hp0 + j) * SP + l0 * 2) = o[j];
                } else { const int n0 = (cbk - 24) * 8; ssd_conv_math<true>(args, l, l0, xcol, nullptr, xa, o);
#pragma unroll
                    for (int j = 0; j < 8; ++j) *(LAS u32x4*)(BT + (n0 + j) * SP + l0 * 2) = o[j]; } }
            __syncthreads();
            f32x4 acc[12];
#pragma unroll
            for (int mi = 0; mi < 12; ++mi) acc[mi] = (f32x4){0.f, 0.f, 0.f, 0.f};
#pragma unroll
            for (int kb = 0; kb < 4; ++kb) { const bf16x8 bf = *(const LAS bf16x8*)(BT + (16 * w + fr) * SP + (32 * kb + 8 * fq) * 2);
#pragma unroll
                for (int mi = 0; mi < 12; ++mi) { const bf16x8 af = *(const LAS bf16x8*)(XT + (16 * mi + fr) * SP + (32 * kb + 8 * fq) * 2);
                    acc[mi] = __builtin_amdgcn_mfma_f32_16x16x32_bf16(bf, af, acc[mi], 0, 0, 0); } }
#pragma unroll
            for (int mi = 0; mi < 12; ++mi) { const int hp = 16 * mi + fr, h = 3 * g + (hp >> 6), p = hp & 63; u32x2 o; o.x = cvt_pk_bf16(acc[mi][0], acc[mi][1]); o.y = cvt_pk_bf16(acc[mi][2], acc[mi][3]);
                *(u32x2*)(ST + (((size_t)chunk * 12 + h) * 64 + p) * 128 + 16 * w + 4 * fq) = o; }
            __syncthreads();
        }
    }
}
__device__ __forceinline__ void ssd_s2(Frame& F, int nwg) {
    unsigned* ST = (unsigned*)(F.ws + WS_ST); const float* CDp = (const float*)(F.ws + WS_CD);
    const int NTH = 2 * 12 * 64 * 64;
    for (int id = F.wg * 512 + F.tid; id < NTH; id += nwg * 512) { const int b = id / (12 * 64 * 64), r = id % (12 * 64 * 64), h = r / 4096;
        float c0 = 0.f, c1 = 0.f;
        for (int c8 = 0; c8 < 128; c8 += 32) { unsigned v[32]; float dec[32];
#pragma unroll
            for (int i = 0; i < 32; ++i) { const int ch = b * 128 + c8 + i; v[i] = ST[(size_t)ch * (12 * 64 * 64) + r]; dec[i] = CDp[ch * 16 + h]; }
#pragma unroll
            for (int i = 0; i < 32; ++i) { const int ch = b * 128 + c8 + i; ST[(size_t)ch * (12 * 64 * 64) + r] = cvt_pk_bf16(c0, c1); c0 = c0 * dec[i] + bflo(v[i]); c1 = c1 * dec[i] + bfhi(v[i]); } } }
}
__device__ __forceinline__ void ssd_s3(CArgs* args, Frame& F, int l) {
    LAS unsigned char* Cs = F.lds;
    LAS unsigned char* Bs = F.lds + 128 * SP;
    LAS unsigned char* XT = F.lds + 256 * SP;
    LAS float* dtv = (LAS float*)(F.lds + 448 * SP);
    LAS float* acs = dtv + 12 * 128;
    const int fr = F.lane & 15, fq = F.lane >> 4, w = F.wave;
    const bf16_t* ST = (const bf16_t*)(F.ws + WS_ST); const bf16_t* proj = (const bf16_t*)(F.ws + WS_PROJ); bf16_t* ycat = (bf16_t*)(F.ws + WS_YCAT); const bf16_t* xp = (const bf16_t*)F.out;
    for (int chunk = F.wg; chunk < 256; chunk += F.G) {
        __syncthreads();
        ssd_tables(args, F, l, chunk, dtv, acs);
        const int lrow = 16 * w + fr; const size_t tok = (size_t)chunk * 128 + lrow;
        float ssq = 0.f;
        bf16x8 pf[16]; u32x2 zq[4];
#define LOAD_HEAD(hh_) do { const bf16_t* prev_ = ST + ((size_t)chunk * 12 + (hh_)) * 64 * 128; \
            _Pragma("unroll") for (int kb_ = 0; kb_ < 4; ++kb_) _Pragma("unroll") for (int ni_ = 0; ni_ < 4; ++ni_) pf[kb_ * 4 + ni_] = *(const bf16x8*)(prev_ + (size_t)(16 * ni_ + fr) * 128 + 32 * kb_ + 8 * fq); \
            _Pragma("unroll") for (int ni_ = 0; ni_ < 4; ++ni_) zq[ni_] = *(const u32x2*)(proj + tok * PLD + 256 + 64 * (hh_) + 16 * ni_ + 4 * fq); } while (0)
        for (int g = 0; g < 4; ++g) {
            __syncthreads();
            for (int id = F.tid; id < 56 * 16; id += 512) { const int rb = (id < 384) ? (id & 15) : ((id - 384) >> 5), cbk = (id < 384) ? (id >> 4) : 24 + ((id - 384) & 31), l0 = rb * 8; u32x4 o[8], xa[11];
                const int xcol = (cbk < 24) ? 192 * g + cbk * 8 : (cbk < 40 ? 768 + 128 * g + (cbk - 24) * 8 : 1280 + 128 * g + (cbk - 40) * 8);
                ssd_conv_load(F, chunk, l0, xcol, xa);
                if (cbk < 24) { const int hp0 = cbk * 8; ssd_conv_math<true>(args, l, l0, xcol, nullptr, xa, o);
#pragma unroll
                    for (int j = 0; j < 8; ++j) *(LAS u32x4*)(XT + (hp0 + j) * SP + l0 * 2) = o[j];
                } else { const bool isB = cbk < 40; const int n0 = (isB ? cbk - 24 : cbk - 40) * 8; ssd_conv_math<false>(args, l, l0, xcol, nullptr, xa, o);
                    LAS unsigned char* dst = isB ? Bs : Cs;
#pragma unroll
                    for (int i = 0; i < 8; ++i) *(LAS u32x4*)(dst + (l0 + i) * SP + n0 * 2) = o[i]; } }
            __syncthreads();
            LOAD_HEAD(3 * g);
            f32x4 cbv[8];
#pragma unroll
            for (int ni = 0; ni < 8; ++ni) cbv[ni] = (f32x4){0.f, 0.f, 0.f, 0.f};
#pragma unroll
            for (int kb = 0; kb < 4; ++kb) { const bf16x8 af = *(const LAS bf16x8*)(Cs + lrow * SP + (32 * kb + 8 * fq) * 2);
#pragma unroll
                for (int ni = 0; ni < 8; ++ni) { const bf16x8 bf = *(const LAS bf16x8*)(Bs + (16 * ni + fr) * SP + (32 * kb + 8 * fq) * 2);
                    cbv[ni] = __builtin_amdgcn_mfma_f32_16x16x32_bf16(bf, af, cbv[ni], 0, 0, 0); } }
            __syncthreads();
            for (int hl = 0; hl < 3; ++hl) { const int h = 3 * g + hl; const float al = acs[h * 128 + lrow];
#pragma unroll
                for (int ni = 0; ni < 8; ++ni) { const int s0 = 16 * ni + 4 * fq; const f32x4 as = *(const LAS f32x4*)(acs + h * 128 + s0), ds = *(const LAS f32x4*)(dtv + h * 128 + s0); float o[4];
#pragma unroll
                    for (int j = 0; j < 4; ++j) o[j] = (s0 + j <= lrow) ? cbv[ni][j] * __expf(al - as[j]) * ds[j] : 0.f;
                    u32x2 pkd; pkd.x = cvt_pk_bf16(o[0], o[1]); pkd.y = cvt_pk_bf16(o[2], o[3]); *(LAS u32x2*)(Bs + lrow * SP + s0 * 2) = pkd; }
                asm volatile("s_waitcnt lgkmcnt(0)" ::: "memory");
                f32x4 acc[4];
#pragma unroll
                for (int ni = 0; ni < 4; ++ni) acc[ni] = (f32x4){0.f, 0.f, 0.f, 0.f};
#pragma unroll
                for (int kb = 0; kb < 4; ++kb) { const bf16x8 af = *(const LAS bf16x8*)(Cs + lrow * SP + (32 * kb + 8 * fq) * 2);
#pragma unroll
                    for (int ni = 0; ni < 4; ++ni) acc[ni] = __builtin_amdgcn_mfma_f32_16x16x32_bf16(pf[kb * 4 + ni], af, acc[ni], 0, 0, 0); }
                const float eal = __expf(al);
#pragma unroll
                for (int ni = 0; ni < 4; ++ni) acc[ni] *= eal;
#pragma unroll
                for (int kb = 0; kb < 4; ++kb) { const bf16x8 af = *(const LAS bf16x8*)(Bs + lrow * SP + (32 * kb + 8 * fq) * 2);
#pragma unroll
                    for (int ni = 0; ni < 4; ++ni) { const bf16x8 bf = *(const LAS bf16x8*)(XT + (64 * hl + 16 * ni + fr) * SP + (32 * kb + 8 * fq) * 2);
                        acc[ni] = __builtin_amdgcn_mfma_f32_16x16x32_bf16(bf, af, acc[ni], 0, 0, 0); } }
                const float dsk = args->in[17][l * 12 + h];
                u32x2 zc[4];
#pragma unroll
                for (int ni = 0; ni < 4; ++ni) zc[ni] = zq[ni];
                if (hl < 2) LOAD_HEAD(h + 1);
#pragma unroll
                for (int ni = 0; ni < 4; ++ni) { const int p0 = 16 * ni + 4 * fq; const u32x2 zz = zc[ni]; float o[4];
#pragma unroll
                    for (int j = 0; j < 4; ++j) { const float xv = bf1(*(const LAS bf16_t*)(XT + (64 * hl + p0 + j) * SP + lrow * 2)); const unsigned zw = (j < 2) ? zz.x : zz.y; const float z = (j & 1) ? bfhi(zw) : bflo(zw);
                        o[j] = (acc[ni][j] + xv * dsk) * silu_f(z); ssq += o[j] * o[j]; }
                    u32x2 pkd; pkd.x = cvt_pk_bf16(o[0], o[1]); pkd.y = cvt_pk_bf16(o[2], o[3]); *(u32x2*)(ycat + tok * D + 256 + 64 * h + p0) = pkd; }
                asm volatile("s_waitcnt lgkmcnt(0)" ::: "memory");
            }
        }
        ssq += __shfl_xor(ssq, 16); ssq += __shfl_xor(ssq, 32);
        { const float ms = ssq * (1.f / 768.f) + EPS; if (fq == 0) *(f32x2*)((float*)(F.ws + WS_RSD) + tok * 2) = (f32x2){rsqrtf(ms), sqrtf(ms)}; }
    }
}
__device__ __forceinline__ void s5_scan(CArgs* args, Frame& F, int l, int wgl, int nwg) {
    const float* hloc = (const float*)(F.ws + WS_HLOC); bf16_t* hprev = (bf16_t*)(F.ws + WS_HPREV);
    LAS float* E = (LAS float*)F.lds;
    for (int bg = wgl; bg < 32; bg += nwg) { const int b = bg >> 4, g = bg & 15, p = F.lane, w = F.wave;
        const float lr = fminf(args->in[4][((size_t)l * 16 + g) * 64 + p], -1e-4f), li = args->in[5][((size_t)l * 16 + g) * 64 + p], dt = __expf(args->in[6][l * 16 + g]);
        const float mag = __expf(32.f * lr * dt); float sn, cs; sincos_rev(32.f * li * dt, sn, cs); const float ar = mag * cs, ai = mag * sn;
        const size_t c0 = (size_t)b * 512 + 64 * w;
        float hr = 0.f, hi = 0.f;
        for (int k8 = 0; k8 < 64; k8 += 16) { float xr[16], xi[16];
#pragma unroll
            for (int i = 0; i < 16; ++i) { const size_t o = ((c0 + k8 + i) * 16 + g) * 128; xr[i] = hloc[o + p]; xi[i] = hloc[o + 64 + p]; }
#pragma unroll
            for (int i = 0; i < 16; ++i) { const float nr = ar * hr - ai * hi + xr[i], ni = ar * hi + ai * hr + xi[i]; hr = nr; hi = ni; } }
        __syncthreads();
        E[(w * 2) * 64 + p] = hr; E[(w * 2 + 1) * 64 + p] = hi;
        __syncthreads();
        float Ar = ar, Ai = ai;
#pragma unroll
        for (int i = 0; i < 6; ++i) { const float t = Ar * Ar - Ai * Ai; Ai = 2.f * Ar * Ai; Ar = t; }
        hr = 0.f; hi = 0.f;
        for (int v = 0; v < w; ++v) { const float er = E[(v * 2) * 64 + p], ei = E[(v * 2 + 1) * 64 + p]; const float nr = Ar * hr - Ai * hi + er, ni = Ar * hi + Ai * hr + ei; hr = nr; hi = ni; }
        for (int k8 = 0; k8 < 64; k8 += 16) { float xr[16], xi[16];
#pragma unroll
            for (int i = 0; i < 16; ++i) { const size_t o = ((c0 + k8 + i) * 16 + g) * 128; xr[i] = hloc[o + p]; xi[i] = hloc[o + 64 + p]; }
#pragma unroll
            for (int i = 0; i < 16; ++i) { const size_t o = ((c0 + k8 + i) * 16 + g) * 256; hprev[o + p] = (bf16_t)(cvt_pk_bf16(hr, hr) & 0xffffu); hprev[o + 64 + p] = (bf16_t)(cvt_pk_bf16(hi, hi) & 0xffffu);
                if (p < 16) *(u32x4*)(hprev + o + 128 + 8 * p) = (u32x4){0u, 0u, 0u, 0u};
                const float nr = ar * hr - ai * hi + xr[i], ni = ar * hi + ai * hr + xi[i]; hr = nr; hi = ni; } } }
}
__device__ __forceinline__ void ffn_fixup(CArgs* args, Frame& F, int l) {
    const float* gf = (const float*)(F.ws + WS_GF); const float* vf = (const float*)(F.ws + WS_VF); const float* gl = (const float*)(F.ws + WS_GL); bf16_t* act = (bf16_t*)(F.ws + WS_ACT);
    const float* cw = args->in[28] + (size_t)l * 3 * DFF; const float* cb = args->in[29] + (size_t)l * DFF;
    for (int v = F.wg * 512 + F.tid; v < 512 * 2 * (DFF / 4); v += F.G * 512) { const int c4 = (v % (DFF / 4)) * 4, qi = v / (DFF / 4), i = qi & 1, q = qi >> 1; const bool bs = (q & 255) == 0;
        const f32x4 z = (f32x4){0.f, 0.f, 0.f, 0.f};
        const f32x4 g0 = *(const f32x4*)(gf + ((size_t)q * 2 + i) * DFF + c4);
        const f32x4 l1 = bs ? z : *(const f32x4*)(gl + ((size_t)(q - 1) * 2 + 1) * DFF + c4), l0 = bs ? z : *(const f32x4*)(gl + ((size_t)(q - 1) * 2 + 0) * DFF + c4);
        const f32x4 g1 = i ? *(const f32x4*)(gf + ((size_t)q * 2) * DFF + c4) : l1, g2 = i ? l1 : l0;
        const f32x4 vv = *(const f32x4*)(vf + ((size_t)q * 2 + i) * DFF + c4);
        const f32x4 gc = *(const f32x4*)(cb + c4) + *(const f32x4*)(cw + 2 * DFF + c4) * g0 + *(const f32x4*)(cw + DFF + c4) * g1 + *(const f32x4*)(cw + c4) * g2;
        u32x2 o; o.x = cvt_pk_bf16(silu_f(gc[0]) * vv[0], silu_f(gc[1]) * vv[1]); o.y = cvt_pk_bf16(silu_f(gc[2]) * vv[2], silu_f(gc[3]) * vv[3]);
        *(u32x2*)(act + ((size_t)q * 64 + i) * DFF + c4) = o; }
}
__device__ __forceinline__ void final_norm(CArgs* args, Frame& F) {
    const float* ssq = (const float*)(F.ws + WS_SSQ); const float* fw = args->in[31]; const bf16_t* xb = (const bf16_t*)(F.ws + WS_XB);
    const int gw = F.wg * 8 + F.wave, NGW = F.G * 8;
    for (int m = gw; m < T; m += NGW) { float s = (F.lane < 16) ? ssq[(size_t)m * 16 + F.lane] : 0.f; s = wave_sum(s); const float rs = rsqrtf(s * (1.f / D) + EPS);
        float* xr = F.out + (size_t)m * D;
#pragma unroll
        for (int j = 0; j < 4; ++j) { const u32x2 v = *(const u32x2*)(xb + (size_t)m * D + 4 * F.lane + 256 * j); const f32x4 w = *(const f32x4*)(fw + 4 * F.lane + 256 * j);
            *(f32x4*)(xr + 4 * F.lane + 256 * j) = (f32x4){bflo(v.x), bfhi(v.x), bflo(v.y), bfhi(v.y)} * rs * w; } }
}

#define XB_TMO      128
#define XB_XCNT(j)  (256  + 64 * (j))
#define XB_XSUB(j)  (1280 + 64 * (j))
#define XB_XGEN(j)  (2304 + 64 * (j))
#define XB_TOP      3328
#define XB_TOPGEN   3392
#define XCD_BAR_WORDS 3456
#define XB_SPIN_CAP (1u << 22)
__device__ __forceinline__ unsigned xb_ld(unsigned* p)              { return __hip_atomic_load(p, __ATOMIC_RELAXED, __HIP_MEMORY_SCOPE_AGENT); }
__device__ __forceinline__ unsigned xb_add(unsigned* p, unsigned v) { return __hip_atomic_fetch_add(p, v, __ATOMIC_RELAXED, __HIP_MEMORY_SCOPE_AGENT); }
__device__ __forceinline__ unsigned xb_xcc_id() { return (unsigned)__builtin_amdgcn_s_getreg((3 << 11) | 20) & 0xFu; }
#define XB_SPIN(cond, bar) do { unsigned _sp = 0; while (cond) { __builtin_amdgcn_s_sleep(1); \
    if ((++_sp & 255u) == 0u) { if (xb_ld(&(bar)[XB_TMO])) break; if (_sp > XB_SPIN_CAP) { atomicAdd(&(bar)[XB_TMO], 1u); break; } } } } while (0)
struct XcdBarrier { unsigned* bar; unsigned x; volatile LAS unsigned* st; };
__device__ __forceinline__ XcdBarrier xcd_barrier_post(unsigned* bar, volatile LAS unsigned* st) {
    XcdBarrier b; b.bar = bar; b.x = xb_xcc_id(); b.st = st;
    if (threadIdx.x == 0) (void)xb_add(&bar[XB_XCNT(b.x)], 1u);
    return b;
}
__device__ __forceinline__ void xcd_barrier_complete(unsigned* bar, unsigned x, unsigned& nloc, unsigned& nx) {
    const unsigned G = gridDim.x * gridDim.y * gridDim.z;
    unsigned sum, cnt, mine, sp = 0u;
    for (;;) {
        sum = 0u; cnt = 0u; mine = 0u;
#pragma unroll
        for (unsigned j = 0; j < 16; ++j) { const unsigned c = xb_ld(&bar[XB_XCNT(j)]); sum += c; cnt += (c > 0u) ? 1u : 0u; mine = (j == x) ? c : mine; }
        if (sum == G) break;
        __builtin_amdgcn_s_sleep(1);
        if ((++sp & 255u) == 0u) { if (xb_ld(&bar[XB_TMO])) break; if (sp > XB_SPIN_CAP) { atomicAdd(&bar[XB_TMO], 1u); break; } }
    }
    nloc = mine > 0u ? mine : 1u; nx = cnt > 0u ? cnt : 1u;
}
__device__ __forceinline__ void xcd_barrier(const XcdBarrier& b) {
    asm volatile("s_waitcnt vmcnt(0)" ::: "memory");
    __syncthreads();
    if (threadIdx.x == 0) {
        unsigned* bar = b.bar;
        __builtin_amdgcn_s_waitcnt(0);
        unsigned nloc = b.st[0], nx = b.st[1];
        if (nloc == 0u) { xcd_barrier_complete(bar, b.x, nloc, nx); b.st[0] = nloc; b.st[1] = nx; }
        const unsigned old = xb_add(&bar[XB_XSUB(b.x)], 1u);
        const unsigned gen = old / nloc;
        if (old + 1u == (gen + 1u) * nloc) {
            __builtin_amdgcn_fence(__ATOMIC_RELEASE, "agent");
            asm volatile("s_waitcnt vmcnt(0)" ::: "memory");
            const unsigned og = xb_add(&bar[XB_TOP], 1u);
            const unsigned tg = og / nx;
            if (og + 1u == (tg + 1u) * nx) xb_add(&bar[XB_TOPGEN], 1u);
            else XB_SPIN(xb_ld(&bar[XB_TOPGEN]) == tg, bar);
            __builtin_amdgcn_fence(__ATOMIC_ACQUIRE, "agent");
            xb_add(&bar[XB_XGEN(b.x)], 1u);
            asm volatile("s_waitcnt vmcnt(0)" ::: "memory");
        } else {
            XB_SPIN(xb_ld(&bar[XB_XGEN(b.x)]) == gen, bar);
            __builtin_amdgcn_fence(__ATOMIC_ACQUIRE, "agent");
            asm volatile("s_waitcnt vmcnt(0)" ::: "memory");
        }
    }
    __syncthreads();
}

__global__ void __launch_bounds__(512, 2) fwd_megakernel(Args args_) {
    extern __shared__ __attribute__((aligned(16))) unsigned char lds_raw[];
    cg::grid_group grid = cg::this_grid();
    Frame F; unsigned char* ws; float* ssq; bf16_t* xb; CArgs* args;
    const int wave0 = __builtin_amdgcn_readfirstlane((int)threadIdx.x >> 6);
#define PHASE_BEGIN() do { int _t; asm volatile("v_mbcnt_lo_u32_b32 %0, -1, 0\n\tv_mbcnt_hi_u32_b32 %0, -1, %0" : "=v"(_t)); _t += wave0 * 64; int _b = blockIdx.x; asm volatile("" : "+s"(_b)); args = (CArgs*)__builtin_amdgcn_kernarg_segment_ptr(); asm volatile("" : "+s"(args)); unsigned char* _w = args->ws; \
        F.lds = (LAS unsigned char*)lds_raw; F.tid = _t; F.lane = _t & 63; F.wave = __builtin_amdgcn_readfirstlane(_t >> 6); F.G = gridDim.x; F.wg = _b; F.ws = _w; F.out = args->out; \
        ws = _w; ssq = (float*)(ws + WS_SSQ); xb = (bf16_t*)(ws + WS_XB); } while (0)
    PHASE_BEGIN();
    { volatile LAS unsigned* misc = (volatile LAS unsigned*)(F.lds + MISC_OFF); if (F.tid < 64) misc[F.tid] = 0u; }
    __syncthreads();
    (void)xcd_barrier_post((unsigned*)args->ws, (volatile LAS unsigned*)(F.lds + MISC_OFF));
    grid.sync();
#ifndef PHM
#define PHM 0xFFFF
#endif

#define SYNC() do { { XcdBarrier xb_; xb_.bar = (unsigned*)args->ws; xb_.x = xb_xcc_id(); xb_.st = (volatile LAS unsigned*)(F.lds + MISC_OFF); xcd_barrier(xb_); } PHASE_BEGIN(); } while (0)
#define MKS(TYPE) TYPE S; S.G = F.G; S.c = F.wg; S.bstride = 0; S.O = nullptr; S.A2 = nullptr; S.B2 = nullptr; S.O2 = nullptr
    attn_prep(args, F);
    __syncthreads();
    prep_phase(args, F, 0, 3);
    SYNC();
    { typedef GS<3, 1024, 1024, 16, 0, 0, 64> ST_; MKS(ST_); S.A = (const char*)ws; EpiStore E{1024}; gemm_phase(F.lds, F.tid, S, E); }
    SYNC();
    { typedef GS<4, 1024, 1024, 4, 0, 0, 256> ST_; MKS(ST_); S.A = (const char*)ws; EpiStore E{1024}; gemm_phase(F.lds, F.tid, S, E); }
    SYNC();
    for (int l = 0; l < NL; ++l) {
#if PHM & (1 << 0)
        for (int rep_ = 0; rep_ <= ((args->dupm >> 0) & 1); ++rep_) {
        if (l > 0 || rep_ > 0) prep_phase(args, F, l, rep_ == 0 ? 3 : ((args->dupm >> 14) & 3));
        if (rep_ < ((args->dupm >> 0) & 1)) SYNC(); }
#endif
        if (l > 0) SYNC();
#if PHM & (1 << 3)
        for (int rep_ = 0; rep_ <= ((args->dupm >> 3) & 1); ++rep_) {
        { typedef GS<0, 1024, 1024, 16, 128, 12, 1536> ST_; MKS(ST_); S.A = (const char*)xb; S.B = (const char*)(ws + WS_WIN);
          EpiProj E{(bf16_t*)(ws + WS_PROJ), (float*)(ws + WS_DT), ssq}; gemm_phase(F.lds, F.tid, S, E); }
        if (rep_ < ((args->dupm >> 3) & 1)) SYNC(); }
#endif
        SYNC();
#if PHM & (1 << 4)
        for (int rep_ = 0; rep_ <= ((args->dupm >> 4) & 1); ++rep_) {
        ssd_s1(args, F, l);
        __syncthreads(); PHASE_BEGIN();
        { typedef GS<1, 0, 512, 8, 0, 0, 192> ST_; MKS(ST_); S.A = (const char*)(ws + WS_PROJ); S.B = (const char*)(ws + WS_S5A);
          EpiS5A E{(bf16_t*)(ws + WS_YPRE), (float*)(ws + WS_HLOC)}; gemm_phase(F.lds, F.tid, S, E); }
        if (rep_ < ((args->dupm >> 4) & 1)) SYNC(); }
#endif
        SYNC();
#if PHM & (1 << 5)
        for (int rep_ = 0; rep_ <= ((args->dupm >> 5) & 1); ++rep_) {
        if (F.wg < F.G - 32) ssd_s2(F, F.G - 32); else s5_scan(args, F, l, F.wg - (F.G - 32), 32);
        if (rep_ < ((args->dupm >> 5) & 1)) SYNC(); }
#endif
        SYNC();
#if PHM & (1 << 6)
        for (int rep_ = 0; rep_ <= ((args->dupm >> 6) & 1); ++rep_) {
        ssd_s3(args, F, l);
        __syncthreads(); PHASE_BEGIN();
        { typedef GS<2, 4096, 256, 4, 0, 0, 128> ST_; MKS(ST_); S.A = (const char*)(ws + WS_HPREV); S.B = (const char*)(ws + WS_S5B);
          EpiS5B E{(const bf16_t*)(ws + WS_YPRE), (bf16_t*)(ws + WS_YG)}; gemm_phase(F.lds, F.tid, S, E); }
        if (rep_ < ((args->dupm >> 6) & 1)) SYNC(); }
#endif
        SYNC();
#if PHM & (1 << 7)
        for (int rep_ = 0; rep_ <= ((args->dupm >> 7) & 1); ++rep_) {
        { typedef GS<0, 256, 256, 4, 128, 1, 128> ST_; MKS(ST_); S.A = (const char*)(ws + WS_YG); S.B = (const char*)(ws + WS_WGLU);
          EpiGlu E{(const bf16_t*)(ws + WS_YG), (bf16_t*)(ws + WS_YCAT), (const float*)(ws + WS_RSD)}; gemm_phase(F.lds, F.tid, S, E); }
        if (rep_ < ((args->dupm >> 7) & 1)) SYNC(); }
#endif
        SYNC();
#if PHM & (1 << 8)
        for (int rep_ = 0; rep_ <= ((args->dupm >> 8) & 1); ++rep_) {
        { typedef GS<0, 1024, 1024, 16, 128, 4, 512> ST_; MKS(ST_); S.A = (const char*)(ws + WS_YCAT); S.B = (const char*)(ws + WS_WOUT);
          EpiRes E{xb, ssq, (const float*)(ws + WS_RSD)}; gemm_phase(F.lds, F.tid, S, E); }
        if (rep_ < ((args->dupm >> 8) & 1)) SYNC(); }
#endif
        SYNC();
#if PHM & (1 << 9)
        for (int rep_ = 0; rep_ <= ((args->dupm >> 9) & 1); ++rep_) {
        { typedef GS<0, 1024, 1024, 16, 128, 4, 512> ST_; MKS(ST_); S.A = (const char*)xb; S.B = (const char*)(ws + WS_WQKA) + (size_t)l * 2 * D * D * 2; S.bstride = (size_t)D * D * 2;
          EpiSoftmax E{(bf16_t*)(ws + WS_P), ssq}; gemm_phase(F.lds, F.tid, S, E); }
        if (rep_ < ((args->dupm >> 9) & 1)) SYNC(); }
#endif
        SYNC();
#if PHM & (1 << 10)
        for (int rep_ = 0; rep_ <= ((args->dupm >> 10) & 1); ++rep_) {
        { typedef GS<0, 1024, 1024, 16, 128, 4, 512> ST_; MKS(ST_); S.A = (const char*)(ws + WS_P); S.B = (const char*)(ws + WS_WVOA) + (size_t)l * 2 * D * D * 2; S.bstride = (size_t)D * D * 2;
          EpiRes E{xb, ssq, nullptr}; gemm_phase(F.lds, F.tid, S, E); }
        if (rep_ < ((args->dupm >> 10) & 1)) SYNC(); }
#endif
        SYNC();
#if PHM & (1 << 11)
        for (int rep_ = 0; rep_ <= ((args->dupm >> 11) & 1); ++rep_) {
        { typedef GS<0, 1024, 1024, 16, 128, 22, 2816> ST_; MKS(ST_); S.A = (const char*)xb; S.B = (const char*)(ws + WS_WUP);
          EpiUp E{(bf16_t*)(ws + WS_ACT), (float*)(ws + WS_GF), (float*)(ws + WS_VF), (float*)(ws + WS_GL), ssq, args->in[28] + (size_t)l * 3 * DFF, args->in[29] + (size_t)l * DFF}; gemm_phase(F.lds, F.tid, S, E); }
        if (rep_ < ((args->dupm >> 11) & 1)) SYNC(); }
#endif
        SYNC();
#if PHM & (1 << 12)
        for (int rep_ = 0; rep_ <= ((args->dupm >> 12) & 1); ++rep_) {
        ffn_fixup(args, F, l);
        if (rep_ < ((args->dupm >> 12) & 1)) SYNC(); }
#endif
        SYNC();
#if PHM & (1 << 13)
        for (int rep_ = 0; rep_ <= ((args->dupm >> 13) & 1); ++rep_) {
        { typedef GS<0, DFF, DFF, 44, 128, 4, 512> ST_; MKS(ST_); S.A = (const char*)(ws + WS_ACT); S.B = (const char*)(ws + WS_WDOWN);
          EpiRes E{xb, ssq, nullptr}; gemm_phase(F.lds, F.tid, S, E); }
        if (rep_ < ((args->dupm >> 13) & 1)) SYNC(); }
#endif
        SYNC();
    }
    final_norm(args, F);
}

extern "C" void kernel_launch(void* const* d_in, const int* in_sizes, int n_in, void* d_out, int out_size, void* d_ws, size_t ws_size, hipStream_t stream) {
    static int grid = 0;
    if (grid == 0) {
        if (n_in != 32 || out_size != T * D || ws_size < WS_END) { fprintf(stderr, "kernel_launch: unexpected shapes (n_in %d out %d ws %zu)\n", n_in, out_size, ws_size); grid = -1; return; }
        int dev = 0, cus = 0, per_cu = 0;
        hipGetDevice(&dev); hipDeviceGetAttribute(&cus, hipDeviceAttributeMultiprocessorCount, dev);
        if (hipFuncSetAttribute((const void*)fwd_megakernel, hipFuncAttributeMaxDynamicSharedMemorySize, LDS_BYTES) != hipSuccess) { fprintf(stderr, "kernel_launch: hipFuncSetAttribute failed\n"); grid = -1; return; }
        hipOccupancyMaxActiveBlocksPerMultiprocessor(&per_cu, (const void*)fwd_megakernel, 512, LDS_BYTES);
        (void)hipGetLastError();
        if (per_cu < 1) per_cu = 1;
        grid = cus * 1;
        fprintf(stderr, "kernel_launch: cus %d per_cu %d grid %d\n", cus, per_cu, grid);
    }
    if (grid < 0) return;
    if (hipMemsetAsync(d_ws, 0, 16384, stream) != hipSuccess) { fprintf(stderr, "kernel_launch: memset failed\n"); return; }
    Args a{};
    a.dupm = PROBE_DUPM; a.sync2 = PROBE_SYNC2;
    for (int i = 0; i < 32; ++i) a.in[i] = (const float*)d_in[i];
    a.out = (float*)d_out; a.ws = (unsigned char*)d_ws;
    void* kargs[] = {&a};
    hipError_t e = hipLaunchCooperativeKernel((const void*)fwd_megakernel, dim3(grid), dim3(512), kargs, LDS_BYTES, stream);
    if (e != hipSuccess) fprintf(stderr, "cooperative launch failed: %s (grid %d)\n", hipGetErrorString(e), grid);
}
```
